# Optimizing an MI355X kernel written in HIP

```python
import math
import jax, jax.numpy as jnp
from jax import lax
import numpy as np

D_MODEL = 1024
BATCH = 32
SEQ = 2048
DEPTH = 4

HEAD_DIM = 64
QBLOCK = 128
A_HEADS = 8
A_KV = 2
A_WINDOW = 128
B_HEADS = 8
B_KV = 2
CMP_BLOCK = 32
CMP_STRIDE = 16
CMP_HIDDEN = 128
SEL_BLOCK = 64
SEL_TOPN = 16
B_WINDOW = 512
SEL_QCHUNK = 16
C_HEADS = 8
BRANCH_WIDTH = 512
N_BRANCH = 3
REL_BUCKETS = 32
REL_MAX_DIST = 128
D_FF = 2816
FFN_RES = 0.5
N_SUB = 3
EPS = 1e-6
IN_WIDTH = (A_HEADS + 2 * A_KV) * HEAD_DIM + (B_HEADS + 6 * B_KV) * HEAD_DIM + 3 * B_HEADS + 3 * C_HEADS * HEAD_DIM + N_BRANCH * D_MODEL

kernel_name = "hybrid_gated_swa_nsa_stickbreak_macaron"


def in_layout():
    widths = [
        ("a_q", A_HEADS * HEAD_DIM), ("a_k", A_KV * HEAD_DIM), ("a_v", A_KV * HEAD_DIM),
        ("b_q", B_HEADS * HEAD_DIM),
        ("b_k_cmp", B_KV * HEAD_DIM), ("b_v_cmp", B_KV * HEAD_DIM),
        ("b_k_slc", B_KV * HEAD_DIM), ("b_v_slc", B_KV * HEAD_DIM),
        ("b_k_win", B_KV * HEAD_DIM), ("b_v_win", B_KV * HEAD_DIM),
        ("b_gate", 3 * B_HEADS),
        ("c_q", C_HEADS * HEAD_DIM), ("c_k", C_HEADS * HEAD_DIM), ("c_v", C_HEADS * HEAD_DIM),
        ("merge_gate", N_BRANCH * D_MODEL),
    ]
    out, off = {}, 0
    for name, w in widths:
        out[name] = (off, off + w)
        off += w
    return out


def rms_norm(x, gain):
    x32 = x.astype(jnp.float32)
    y = x32 * lax.rsqrt(jnp.mean(x32 * x32, axis=-1, keepdims=True) + EPS)
    return (y * gain.astype(jnp.float32)).astype(x.dtype)


def swiglu(h, w_gate, w_up, w_down):
    return (jax.nn.silu(h @ w_gate) * (h @ w_up)) @ w_down


def t5_bucket(dist):
    max_exact = REL_BUCKETS // 2
    d = jnp.maximum(dist, 0)
    ratio = jnp.log(jnp.maximum(d, 1).astype(jnp.float32) / max_exact) / math.log(REL_MAX_DIST / max_exact)
    large = jnp.minimum(max_exact + (ratio * (REL_BUCKETS - max_exact)).astype(jnp.int32), REL_BUCKETS - 1)
    return jnp.where(d < max_exact, d, large)


def masked_softmax(logits, mask):
    logits = jnp.where(mask, logits.astype(jnp.float32), -1e30)
    m = jnp.max(logits, axis=-1, keepdims=True)
    e = jnp.where(mask, jnp.exp(logits - m), 0.0)
    s = jnp.sum(e, axis=-1, keepdims=True)
    return e / jnp.where(s > 0, s, 1.0)


def band_bias(table, window):
    dist = window + jnp.arange(QBLOCK)[:, None] - jnp.arange(window + QBLOCK)[None, :]
    return jnp.moveaxis(table[t5_bucket(dist)], -1, 0).astype(jnp.float32)


def banded_attention(q, k, v, bias, window, sink):
    bsz, g, hpg, s, dh = q.shape
    nblk = s // QBLOCK
    span = window + QBLOCK
    kp = jnp.pad(k, ((0, 0), (0, 0), (window, 0), (0, 0)))
    vp = jnp.pad(v, ((0, 0), (0, 0), (window, 0), (0, 0)))
    qb = jnp.moveaxis(q.reshape(bsz, g, hpg, nblk, QBLOCK, dh), 3, 0)
    iq = jnp.arange(QBLOCK)[:, None]
    jk = jnp.arange(span)[None, :]
    dist = window + iq - jk
    in_band = (dist >= 0) & (dist < window)
    scale = 1.0 / math.sqrt(dh)

    def block(args):
        qi, blk = args
        start = blk * QBLOCK
        kb = lax.dynamic_slice_in_dim(kp, start, span, axis=2)
        vb = lax.dynamic_slice_in_dim(vp, start, span, axis=2)
        mask = in_band & (start - window + jk >= 0)
        logits = jnp.einsum('bghqd,bgkd->bghqk', qi, kb).astype(jnp.float32) * scale + bias
        logits = jnp.where(mask, logits, -1e30)
        if sink is None:
            p = jax.nn.softmax(logits, axis=-1)
        else:
            sk = sink.astype(jnp.float32)[None, :, :, None, None]
            m = jnp.maximum(jnp.max(logits, axis=-1, keepdims=True), sk)
            e = jnp.exp(logits - m)
            p = e / (jnp.sum(e, axis=-1, keepdims=True) + jnp.exp(sk - m))
        return jnp.einsum('bghqk,bgkd->bghqd', p.astype(vb.dtype), vb)

    out = lax.map(block, (qb, jnp.arange(nblk)))
    return jnp.moveaxis(out, 0, 3).reshape(bsz, g, hpg, s, dh)


def swa_sink_attention(q, k, v, sinks, rel_table_a):
    bsz, s, _ = q.shape
    hpg = A_HEADS // A_KV
    qh = q.reshape(bsz, s, A_KV, hpg, HEAD_DIM).transpose(0, 2, 3, 1, 4)
    kh = k.reshape(bsz, s, A_KV, HEAD_DIM).transpose(0, 2, 1, 3)
    vh = v.reshape(bsz, s, A_KV, HEAD_DIM).transpose(0, 2, 1, 3)
    bias = band_bias(rel_table_a, A_WINDOW).reshape(A_KV, hpg, QBLOCK, A_WINDOW + QBLOCK)
    o = banded_attention(qh, kh, vh, bias, A_WINDOW, sinks.reshape(A_KV, hpg))
    return o.transpose(0, 3, 1, 2, 4).reshape(bsz, s, A_HEADS * HEAD_DIM)


def nsa_compress(kv, pos, w1, w2):
    bsz, s, _ = kv.shape
    ncmp = (s - CMP_BLOCK) // CMP_STRIDE + 1
    kv_r = kv.reshape(bsz, s, B_KV, HEAD_DIM)
    idx = jnp.arange(ncmp)[:, None] * CMP_STRIDE + jnp.arange(CMP_BLOCK)[None, :]
    blocks = kv_r[:, idx] + pos[None, None, :, None, :]
    flat = blocks.transpose(0, 3, 1, 2, 4).reshape(bsz, B_KV, ncmp, CMP_BLOCK * HEAD_DIM)
    return jax.nn.gelu(flat @ w1) @ w2


def nsa_selected_attention(qh, k_slc, v_slc, sel_idx, rel_table_b):
    bsz, g, hpg, s, dh = qh.shape
    nsel = s // SEL_BLOCK
    n_top = sel_idx.shape[-1]
    nk = n_top * SEL_BLOCK
    nchunk = s // SEL_QCHUNK
    kb = k_slc.reshape(bsz, nsel, SEL_BLOCK, g, dh).transpose(0, 3, 1, 2, 4)
    vb = v_slc.reshape(bsz, nsel, SEL_BLOCK, g, dh).transpose(0, 3, 1, 2, 4)
    qc = jnp.moveaxis(qh.reshape(bsz, g, hpg, nchunk, SEL_QCHUNK, dh), 3, 0)
    ic = jnp.moveaxis(sel_idx.reshape(bsz, g, nchunk, SEL_QCHUNK, n_top), 2, 0)
    tc = jnp.arange(s).reshape(nchunk, SEL_QCHUNK)
    table = rel_table_b.reshape(REL_BUCKETS, g, hpg).transpose(1, 0, 2)
    gidx = jnp.arange(g)[None, :, None, None]
    gather = jax.vmap(jax.vmap(lambda blocks, ix: blocks[ix]))
    scale = 1.0 / math.sqrt(dh)

    def chunk(args):
        qi, ii, ti = args
        kg = gather(kb, ii).reshape(bsz, g, SEL_QCHUNK, nk, dh)
        vg = gather(vb, ii).reshape(bsz, g, SEL_QCHUNK, nk, dh)
        kpos = (ii[..., None] * SEL_BLOCK + jnp.arange(SEL_BLOCK)).reshape(bsz, g, SEL_QCHUNK, nk)
        dist = ti[None, None, :, None] - kpos
        bias = jnp.moveaxis(table[gidx, t5_bucket(dist)], -1, 2)
        logits = jnp.einsum('bghqd,bgqkd->bghqk', qi, kg).astype(jnp.float32) * scale + bias
        p = masked_softmax(logits, (dist >= 0)[:, :, None])
        return jnp.einsum('bghqk,bgqkd->bghqd', p.astype(vg.dtype), vg)

    out = lax.map(chunk, (qc, ic, tc))
    return jnp.moveaxis(out, 0, 3).reshape(bsz, g, hpg, s, dh)


def nsa_attention(q, k_cmp, v_cmp, k_slc, v_slc, k_win, v_win, gate_logits, cmp_pos, cmp_w1, cmp_w2, rel_table_b):
    bsz, s, _ = q.shape
    g, hpg = B_KV, B_HEADS // B_KV
    qh = q.reshape(bsz, s, g, hpg, HEAD_DIM).transpose(0, 2, 3, 1, 4)
    t = jnp.arange(s)
    scale = 1.0 / math.sqrt(HEAD_DIM)
    kc = nsa_compress(k_cmp, cmp_pos[0], cmp_w1[0], cmp_w2[0])
    vc = nsa_compress(v_cmp, cmp_pos[1], cmp_w1[1], cmp_w2[1])
    ncmp = kc.shape[2]
    cstart = jnp.arange(ncmp) * CMP_STRIDE
    cmp_mask = (cstart + CMP_BLOCK - 1)[None, :] <= t[:, None]
    logits_c = jnp.einsum('bghsd,bgnd->bghsn', qh, kc).astype(jnp.float32) * scale
    p_cmp = masked_softmax(logits_c, cmp_mask)
    o_cmp = jnp.einsum('bghsn,bgnd->bghsd', p_cmp.astype(vc.dtype), vc)
    nsel = s // SEL_BLOCK
    sstart = jnp.arange(nsel) * SEL_BLOCK
    overlap = ((cstart[:, None] < sstart[None, :] + SEL_BLOCK) & (cstart[:, None] + CMP_BLOCK > sstart[None, :])).astype(jnp.float32)
    imp = jnp.einsum('bgsn,nj->bgsj', jnp.sum(p_cmp, axis=2), overlap)
    cur = t // SEL_BLOCK
    jsel = jnp.arange(nsel)[None, :]
    forced = (jsel == 0) | (jsel == cur[:, None]) | (jsel == cur[:, None] - 1)
    future = sstart[None, :] > t[:, None]
    prio = jnp.where(forced, jnp.inf, jnp.where(future, -jnp.inf, imp))
    _, sel_idx = lax.top_k(prio, min(SEL_TOPN, nsel))
    o_slc = nsa_selected_attention(qh, k_slc, v_slc, sel_idx, rel_table_b)
    kw = k_win.reshape(bsz, s, g, HEAD_DIM).transpose(0, 2, 1, 3)
    vw = v_win.reshape(bsz, s, g, HEAD_DIM).transpose(0, 2, 1, 3)
    bias_w = band_bias(rel_table_b, B_WINDOW).reshape(g, hpg, QBLOCK, B_WINDOW + QBLOCK)
    o_win = banded_attention(qh, kw, vw, bias_w, B_WINDOW, None)
    gates = jax.nn.sigmoid(gate_logits.astype(jnp.float32)).reshape(bsz, s, 3, g, hpg).transpose(2, 0, 3, 4, 1)[..., None]
    gates = gates.astype(q.dtype)
    o = gates[0] * o_cmp + gates[1] * o_slc + gates[2] * o_win
    return o.transpose(0, 3, 1, 2, 4).reshape(bsz, s, B_HEADS * HEAD_DIM)


def stick_breaking_attention(q, k, v):
    bsz, s, _ = q.shape
    qh = q.reshape(bsz, s, C_HEADS, HEAD_DIM).transpose(0, 2, 1, 3)
    kh = k.reshape(bsz, s, C_HEADS, HEAD_DIM).transpose(0, 2, 1, 3)
    vh = v.reshape(bsz, s, C_HEADS, HEAD_DIM).transpose(0, 2, 1, 3)
    scale = 1.0 / math.sqrt(HEAD_DIM)
    outs = []
    for blk in range(s // QBLOCK):
        s0, s1 = blk * QBLOCK, (blk + 1) * QBLOCK
        z = jnp.einsum('bhqd,bhkd->bhqk', qh[:, :, s0:s1], kh[:, :, :s1]).astype(jnp.float32) * scale
        strict = jnp.arange(s1)[None, :] < jnp.arange(s0, s1)[:, None]
        log_keep = jnp.where(strict, jax.nn.log_sigmoid(-z), 0.0)
        later = lax.cumsum(log_keep, axis=3, reverse=True) - log_keep
        w = jnp.where(strict, jnp.exp(jax.nn.log_sigmoid(z) + later), 0.0)
        outs.append(jnp.einsum('bhqk,bhkd->bhqd', w.astype(vh.dtype), vh[:, :, :s1]))
    o = jnp.concatenate(outs, axis=2)
    return o.transpose(0, 2, 1, 3).reshape(bsz, s, C_HEADS * HEAD_DIM)


def token_mixing(u, w_in, sinks, cmp_pos, cmp_w1, cmp_w2, w_branch, w_out, rel_bias):
    lay = in_layout()

    def proj(name):
        a, b = lay[name]
        return u @ w_in[:, a:b]

    y_a = swa_sink_attention(proj("a_q"), proj("a_k"), proj("a_v"), sinks, rel_bias[:, :A_HEADS])
    y_b = nsa_attention(proj("b_q"), proj("b_k_cmp"), proj("b_v_cmp"), proj("b_k_slc"), proj("b_v_slc"),
                        proj("b_k_win"), proj("b_v_win"), proj("b_gate"), cmp_pos, cmp_w1, cmp_w2,
                        rel_bias[:, A_HEADS:A_HEADS + B_HEADS])
    y_c = stick_breaking_attention(proj("c_q"), proj("c_k"), proj("c_v"))
    bsz, s, _ = u.shape
    gates = jax.nn.sigmoid(proj("merge_gate")).reshape(bsz, s, N_BRANCH, D_MODEL)
    merged = (gates[:, :, 0] * (y_a @ w_branch[0]) + gates[:, :, 1] * (y_b @ w_branch[1])
              + gates[:, :, 2] * (y_c @ w_branch[2]))
    return merged @ w_out


def sandwich(x, mod, i, ln_pre, ln_post, fn, res_w):
    shift, scale, gate = mod[:, i, 0][:, None, :], mod[:, i, 1][:, None, :], mod[:, i, 2][:, None, :]
    h = rms_norm(x, ln_pre[i]) * (1 + scale) + shift
    return x + res_w * gate * rms_norm(fn(h), ln_post[i])


def setup_inputs(seed: int = 0) -> dict:
    key = jax.random.key(seed)
    ks = jax.random.split(key, 20)
    f32 = jnp.float32

    def nrm(k, shape, scale):
        return jax.random.normal(k, shape, f32) * scale

    D = D_MODEL
    return {
        "x": nrm(ks[0], (BATCH, SEQ, D), 1.0),
        "c": nrm(ks[1], (BATCH, D), 1.0),
        "rel_bias": nrm(ks[2], (REL_BUCKETS, A_HEADS + B_HEADS), 0.5),
        "ada_w": nrm(ks[3], (DEPTH, D, N_SUB * 3 * D), 0.5 * D ** -0.5),
        "ada_b": nrm(ks[4], (DEPTH, N_SUB * 3 * D), 0.02),
        "ln_pre": 1.0 + nrm(ks[5], (DEPTH, N_SUB, D), 0.02),
        "ln_post": 1.0 + nrm(ks[6], (DEPTH, N_SUB, D), 0.02),
        "ffn_w_gate": nrm(ks[7], (DEPTH, 2, D, D_FF), D ** -0.5),
        "ffn_w_up": nrm(ks[8], (DEPTH, 2, D, D_FF), D ** -0.5),
        "ffn_w_down": nrm(ks[9], (DEPTH, 2, D_FF, D), D_FF ** -0.5),
        "w_in": nrm(ks[10], (DEPTH, D, IN_WIDTH), D ** -0.5),
        "attn_sinks": nrm(ks[11], (DEPTH, A_HEADS), 1.0),
        "cmp_pos": nrm(ks[12], (DEPTH, 2, CMP_BLOCK, HEAD_DIM), 0.1),
        "cmp_w1": nrm(ks[13], (DEPTH, 2, CMP_BLOCK * HEAD_DIM, CMP_HIDDEN), (CMP_BLOCK * HEAD_DIM) ** -0.5),
        "cmp_w2": nrm(ks[14], (DEPTH, 2, CMP_HIDDEN, HEAD_DIM), CMP_HIDDEN ** -0.5),
        "w_branch": nrm(ks[15], (DEPTH, N_BRANCH, BRANCH_WIDTH, D), BRANCH_WIDTH ** -0.5),
        "w_out": nrm(ks[16], (DEPTH, D, D), D ** -0.5),
    }


def reference(x, c, rel_bias, ada_w, ada_b, ln_pre, ln_post, ffn_w_gate, ffn_w_up, ffn_w_down,
              w_in, attn_sinks, cmp_pos, cmp_w1, cmp_w2, w_branch, w_out):
    bsz = x.shape[0]
    c_act = jax.nn.silu(c)
    for l in range(DEPTH):
        mod = (c_act @ ada_w[l] + ada_b[l]).reshape(bsz, N_SUB, 3, D_MODEL)
        x = sandwich(x, mod, 0, ln_pre[l], ln_post[l],
                     lambda h: swiglu(h, ffn_w_gate[l, 0], ffn_w_up[l, 0], ffn_w_down[l, 0]), FFN_RES)
        x = sandwich(x, mod, 1, ln_pre[l], ln_post[l],
                     lambda h: token_mixing(h, w_in[l], attn_sinks[l], cmp_pos[l], cmp_w1[l], cmp_w2[l],
                                            w_branch[l], w_out[l], rel_bias), 1.0)
        x = sandwich(x, mod, 2, ln_pre[l], ln_post[l],
                     lambda h: swiglu(h, ffn_w_gate[l, 1], ffn_w_up[l, 1], ffn_w_down[l, 1]), FFN_RES)
    return x
```

```cpp
#include <hip/hip_runtime.h>
#include <hip/hip_cooperative_groups.h>
#include <cstdio>
#include <cstdint>
namespace cg = cooperative_groups;

#ifndef MK_PER_PHASE_LAUNCH
#define MK_PER_PHASE_LAUNCH 0
#endif

#ifndef PHMASK
#define PHMASK 0xFFFF
#endif
#define PHON(k) ((PHMASK >> (k)) & 1)
#ifndef REPMASK
#define REPMASK 0
#endif
#define NREP(k) (1 + ((REPMASK >> (k)) & 1))
#define LAS __attribute__((address_space(3)))
typedef unsigned short bf16_t;
typedef short bf16x8 __attribute__((ext_vector_type(8)));
typedef float f32x4 __attribute__((ext_vector_type(4)));
typedef float f32x2 __attribute__((ext_vector_type(2)));
typedef unsigned u32x4 __attribute__((ext_vector_type(4)));
typedef unsigned u32x2 __attribute__((ext_vector_type(2)));
typedef __bf16 bf16x2_t __attribute__((ext_vector_type(2)));

constexpr int BATCH = 32, SEQ = 2048, DM = 1024, M = BATCH * SEQ, DEPTH = 4, FF = 2816;
constexpr int INW = 6680;
constexpr int QP = 3608;
constexpr int NIN = 3840;
constexpr int NMG = 3072;
constexpr float EPS = 1e-6f;
constexpr int C_AQ = 0, C_AK = 512, C_AV = 640, C_BQ = 768, C_BKC = 1280, C_BVC = 1408, C_BKS = 1536, C_BVS = 1664, C_BKW = 1792, C_BVW = 1920,
              C_CQ = 2048, C_CK = 2560, C_CV = 3072, C_BG = 3584;
constexpr size_t MiB = 1u << 20;
constexpr size_t WS_MOD = 1 * MiB;
constexpr size_t WS_KC = 6 * MiB;
constexpr size_t WS_SEL = 8 * MiB;
constexpr size_t WS_HB = 9 * MiB;
constexpr size_t WS_W = 10 * MiB;
constexpr size_t WS_H = 64 * MiB;
constexpr size_t WS_BIG = 192 * MiB;
constexpr size_t WS_Y = 644 * MiB;
constexpr size_t WS_YCMP = 900 * MiB;
constexpr size_t WS_WB = 964 * MiB;
constexpr size_t WS_END = 970 * MiB;
constexpr int YP = 1024;
constexpr size_t W_GU = 0, W_D = 11534336, W_IN = 17301504, W_B = 24379392, W_O = 25952256, W_1 = 27000832, W_2 = 27525120;

constexpr int LDS_BYTES = 147456;

__device__ __constant__ unsigned char T5B[128] = {0, 1, 2, 3, 4, 5, 6, 7, 8, 9, 10, 11, 12, 13, 14, 15, 16, 16, 16, 17, 17, 18, 18, 18, 19, 19, 19, 20, 20, 20, 20, 21, 21, 21, 21, 22, 22, 22, 22, 22, 23, 23, 23, 23, 23, 23, 24, 24, 24, 24, 24, 24, 25, 25, 25, 25, 25, 25, 25, 26, 26, 26, 26, 26, 26, 26, 26, 27, 27, 27, 27, 27, 27, 27, 27, 27, 27, 28, 28, 28, 28, 28, 28, 28, 28, 28, 28, 29, 29, 29, 29, 29, 29, 29, 29, 29, 29, 29, 29, 30, 30, 30, 30, 30, 30, 30, 30, 30, 30, 30, 30, 30, 30, 31, 31, 31, 31, 31, 31, 31, 31, 31, 31, 31, 31, 31, 31, 31};

__device__ __forceinline__ unsigned cvtpk(float lo, float hi) { f32x2 v = {lo, hi}; bf16x2_t b = __builtin_convertvector(v, bf16x2_t); return __builtin_bit_cast(unsigned, b); }
__device__ __forceinline__ float bf2f(unsigned short u) { return __uint_as_float((unsigned)u << 16); }
__device__ __forceinline__ float bflo(unsigned u) { return __uint_as_float(u << 16); }
__device__ __forceinline__ float bfhi(unsigned u) { return __uint_as_float(u & 0xffff0000u); }
__device__ __forceinline__ float fast_rcp(float x) { return __builtin_amdgcn_rcpf(x); }
__device__ __forceinline__ float sigmoidf_(float x) { return fast_rcp(1.f + __expf(-x)); }

namespace pg8 {
constexpr int BM = 256, BK = 64, HALF = 128, HTB = HALF * BK * 2, STAGE_BYTES = 8 * HTB, NXCD = 8, WGM = 8;
__host__ __device__ __forceinline__ int lds_byte(int r, int c) { const int st = (r >> 4) * 2 + (c >> 5), rr = r & 15, cc = c & 31, ob = rr * 64 + cc * 2; return st * 1024 + (ob ^ (((ob >> 9) & 1) << 5)); }
__host__ __device__ __forceinline__ void stage_rc(int b, int& R, int& C) { const int st = b / 1024, sb = b % 1024, swz = sb ^ (((sb >> 9) & 1) << 5); R = (st >> 1) * 16 + swz / 64; C = (st & 1) * 32 + (swz % 64) / 2; }
__host__ __device__ __forceinline__ int perm32(int rho) { const int n = rho >> 4, i = rho & 15; return 8 * (i >> 2) + 4 * n + (i & 3); }
struct Unit { const char* A; const char* B; int nt; int pm, pn; int em, br; };
struct Gemm { int ld; };
struct StaticOrder {
    int nM, nN, nwg, G, c; int fused; const char* A; const char* B; size_t tstep; int nt; int em;
    const char* Hh; const char* Wmg; const char* Yab; const char* Yc; const char* WbT;
    __device__ void init(int M_, int N_, int G_, int c_) { nM = M_ / BM; nN = N_ / BM; nwg = nM * nN; G = G_; c = c_; fused = 0; }
    __device__ __forceinline__ bool tile(long L, int& pm, int& pn) const {
        if (L >= nwg) return false;
        int wgid = (int)L; { const int q = nwg / NXCD, r = nwg % NXCD, xcd = wgid % NXCD, off = wgid / NXCD; wgid = (xcd < r ? xcd * (q + 1) : r * (q + 1) + (xcd - r) * q) + off; }
        const int nig = WGM * nN, gid = wgid / nig, fm = gid * WGM, gsz = (nM - fm) < WGM ? (nM - fm) : WGM;
        pm = fm + ((wgid % nig) % gsz); pn = (wgid % nig) / gsz; return true;
    }
    __device__ __forceinline__ bool next(int i, Unit& u) const {
        if (!fused) {
            if (!tile((long)i * G + c, u.pm, u.pn)) return false;
            u.A = A + (size_t)u.pm * tstep; u.B = B + (size_t)u.pn * tstep; u.nt = nt; u.em = em; u.br = 0; return true;
        }
        const int t = i / 6, sub = i - 6 * t;
        if (!tile((long)t * G + c, u.pm, u.pn)) return false;
        const int br = sub >> 1; u.br = br;
        if ((sub & 1) == 0) { u.A = Hh + (size_t)u.pm * tstep; u.B = Wmg + (size_t)(br * 4 + u.pn) * tstep; u.nt = 16; u.em = 5; }
        else { u.A = (br == 0 ? Yab : br == 1 ? Yab + 512 * 2 : Yc) + (size_t)u.pm * tstep; u.B = WbT + (size_t)(br * 4 + u.pn) * tstep; u.nt = 8; u.em = 6; }
        return true;
    }
};
struct EpiGen {
    bf16_t* O; int ldc; int ncols; bf16_t* sG; bf16_t* sM;
    __device__ __forceinline__ void operator()(const f32x4 (&acc)[2][2][4][2], const Unit& u, int wr, int wc, int fr, int fq) const {
        const int mode = u.em;
        int fr_ = fr; asm volatile("" : "+v"(fr_));
        const int rl0 = wr * 64 + fr_, cl0 = wc * 32 + 8 * fq;
        if (mode == 2) {
            const int par = fq & 1;
#pragma unroll
            for (int ai = 0; ai < 2; ++ai)
#pragma unroll
                for (int bj = 0; bj < 2; ++bj) { const int acol = ((u.pn * BM + bj * HALF + wc * 32) >> 1) + 4 * (fq - par);
#pragma unroll
                    for (int mp = 0; mp < 4; mp += 2) {
                        u32x2 wk[2];
#pragma unroll
                        for (int q = 0; q < 2; ++q) { const f32x4 v0 = acc[ai][bj][mp + q][0], v1 = acc[ai][bj][mp + q][1]; float r[4];
#pragma unroll
                            for (int e = 0; e < 4; ++e) r[e] = v0[e] * sigmoidf_(v0[e]) * v1[e];
                            wk[q].x = cvtpk(r[0], r[1]); wk[q].y = cvtpk(r[2], r[3]); }
                        const auto sx = __builtin_amdgcn_permlane16_swap(wk[0].x, wk[1].x, false, false);
                        const auto sy = __builtin_amdgcn_permlane16_swap(wk[0].y, wk[1].y, false, false);
                        u32x4 w; w.x = sx[0]; w.y = sy[0]; w.z = sx[1]; w.w = sy[1];
                        const size_t row = (size_t)(u.pm * BM + rl0 + ai * HALF + (mp + par) * 16);
                        *(u32x4*)(O + row * ldc + acol) = w; } }
            return;
        }
#pragma unroll
        for (int ai = 0; ai < 2; ++ai)
#pragma unroll
            for (int m = 0; m < 4; ++m) { const int rl = rl0 + ai * HALF + m * 16; const size_t row = (size_t)(u.pm * BM + rl); bf16_t* rowp = O + row * ldc;
#pragma unroll
                for (int bj = 0; bj < 2; ++bj) { const int cl = cl0 + bj * HALF; const int col0 = u.pn * BM + cl; f32x4 v0 = acc[ai][bj][m][0], v1 = acc[ai][bj][m][1];
                    if (mode == 2) {
                        float r[4];
#pragma unroll
                        for (int e = 0; e < 4; ++e) r[e] = v0[e] * sigmoidf_(v0[e]) * v1[e];
                        u32x2 w; w.x = cvtpk(r[0], r[1]); w.y = cvtpk(r[2], r[3]);
                        *(u32x2*)(rowp + (col0 >> 1)) = w;
                    } else {
                        if (mode == 1 || mode == 5) {
#pragma unroll
                            for (int e = 0; e < 4; ++e) { v0[e] = sigmoidf_(v0[e]); v1[e] = sigmoidf_(v1[e]); } }
                        if (mode == 6) {
                            const u32x4 gq = *(const u32x4*)(sG + rl * 256 + cl);
                            v0[0] *= bflo(gq.x); v0[1] *= bfhi(gq.x); v0[2] *= bflo(gq.y); v0[3] *= bfhi(gq.y); v1[0] *= bflo(gq.z); v1[1] *= bfhi(gq.z); v1[2] *= bflo(gq.w); v1[3] *= bfhi(gq.w);
                            if (u.br > 0) { const u32x4 mo = *(const u32x4*)(sM + rl * 256 + cl);
                                v0[0] += bflo(mo.x); v0[1] += bfhi(mo.x); v0[2] += bflo(mo.y); v0[3] += bfhi(mo.y); v1[0] += bflo(mo.z); v1[1] += bfhi(mo.z); v1[2] += bflo(mo.w); v1[3] += bfhi(mo.w); } }
                        u32x4 w; w.x = cvtpk(v0[0], v0[1]); w.y = cvtpk(v0[2], v0[3]); w.z = cvtpk(v1[0], v1[1]); w.w = cvtpk(v1[2], v1[3]);
                        if (mode == 5) *(u32x4*)(sG + rl * 256 + cl) = w;
                        else if (mode == 6 && u.br < 2) *(u32x4*)(sM + rl * 256 + cl) = w;
                        else if (col0 < ncols) *(u32x4*)(rowp + col0) = w; } } }
    }
};

constexpr int UTAB_OFF = 131072, UTAB_MAX = 64;
__device__ __forceinline__ void utab_build(LAS unsigned char* lds, const StaticOrder& S, int tid) {
    if (tid < UTAB_MAX) { Unit u; u.A = nullptr; u.B = nullptr; u.nt = 0; u.pm = 0; u.pn = 0; u.em = 0; u.br = 0; const bool ok = S.next(tid, u);
        LAS unsigned* e = (LAS unsigned*)(lds + UTAB_OFF + tid * 32); const unsigned long long a = (unsigned long long)(uintptr_t)u.A, b = (unsigned long long)(uintptr_t)u.B;
        e[0] = (unsigned)a; e[1] = (unsigned)(a >> 32); e[2] = (unsigned)b; e[3] = (unsigned)(b >> 32); e[4] = ok ? (unsigned)u.nt : 0u; e[5] = (unsigned)u.pm; e[6] = (unsigned)u.pn; e[7] = (unsigned)(u.em | (u.br << 8)); }
    __syncthreads();
}
struct TabSched {
    LAS unsigned char* lds;
    __device__ __forceinline__ bool next(int i, Unit& u) const {
        if (i >= UTAB_MAX) return false;
        const LAS unsigned* e = (const LAS unsigned*)(lds + UTAB_OFF + i * 32);
        const u32x4 lo = *(const LAS u32x4*)e, hi = *(const LAS u32x4*)(e + 4);
        const unsigned nt = __builtin_amdgcn_readfirstlane(hi.x); if (nt == 0u) return false;
        const unsigned a0 = __builtin_amdgcn_readfirstlane(lo.x), a1 = __builtin_amdgcn_readfirstlane(lo.y), b0 = __builtin_amdgcn_readfirstlane(lo.z), b1 = __builtin_amdgcn_readfirstlane(lo.w);
        u.A = (const char*)(uintptr_t)(((unsigned long long)a1 << 32) | a0); u.B = (const char*)(uintptr_t)(((unsigned long long)b1 << 32) | b0);
        u.nt = (int)nt; u.pm = (int)__builtin_amdgcn_readfirstlane(hi.y); u.pn = (int)__builtin_amdgcn_readfirstlane(hi.z);
        const unsigned eb = __builtin_amdgcn_readfirstlane(hi.w); u.em = (int)(eb & 255u); u.br = (int)(eb >> 8); return true;
    }
};
template <class Epi>
__device__ __forceinline__ void gemm_phase(LAS unsigned char* lds, const Gemm g, const TabSched& S, const Epi& E) {
    int tid_ = threadIdx.x; asm volatile("" : "+v"(tid_));
    const int tid = tid_, wid = __builtin_amdgcn_readfirstlane(tid >> 6), lane = tid & 63, wr = wid >> 2, wc = wid & 3, fr = lane & 15, fq = lane >> 4;
    const int K = g.ld;
    unsigned voffA[2], voffB[2];
#pragma unroll
    for (int i = 0; i < 2; ++i) { int R, C; stage_rc(tid * 16 + i * 8192, R, C); const int Rb = (R & ~31) + perm32(R & 31);
        voffA[i] = (unsigned)(R * K + C) * 2u; voffB[i] = (unsigned)(Rb * K + C) * 2u; }
    const size_t kstep = (size_t)(BK * 2);
    const size_t hstep = (size_t)HALF * K * 2;
    const unsigned ldsw = (unsigned)wid * 1024u;
    const int aoff = lds_byte(wr * 64 + fr, fq * 8), boff = lds_byte(wc * 32 + fr, fq * 8);
#define PG8_SA(b, h) (((b) * 2 + (h)) * HTB)
#define PG8_SB(b, h) ((4 + (b) * 2 + (h)) * HTB)
#define PG8_STAGE(bufoff, gbase, voff) do { _Pragma("unroll") for (int _i = 0; _i < 2; ++_i) \
        __builtin_amdgcn_global_load_lds((const unsigned*)((const char*)(gbase) + (voff)[_i]), (LAS unsigned*)(lds + (bufoff) + ldsw + _i * 8192), 16, 0, 0); } while (0)
#define PG8_LDA(dst, b, h) do { _Pragma("unroll") for (int m = 0; m < 4; ++m) _Pragma("unroll") for (int k = 0; k < 2; ++k) dst[m][k] = *(const LAS bf16x8*)(lds + PG8_SA(b, h) + aoff + m * 2048 + k * 1024); } while (0)
#define PG8_LDB(dst, b, h) do { _Pragma("unroll") for (int n = 0; n < 2; ++n) _Pragma("unroll") for (int k = 0; k < 2; ++k) dst[n][k] = *(const LAS bf16x8*)(lds + PG8_SB(b, h) + boff + n * 2048 + k * 1024); } while (0)
#define PG8_MMA(ai, bj, At, Bt) do { __builtin_amdgcn_s_setprio(1); _Pragma("unroll") for (int m = 0; m < 4; ++m) _Pragma("unroll") for (int n = 0; n < 2; ++n) _Pragma("unroll") for (int k = 0; k < 2; ++k) \
        acc[ai][bj][m][n] = __builtin_amdgcn_mfma_f32_16x16x32_bf16(Bt[n][k], At[m][k], acc[ai][bj][m][n], 0, 0, 0); __builtin_amdgcn_s_setprio(0); } while (0)
#define PG8_WAIT_V(n) asm volatile("s_waitcnt vmcnt(" #n ")" ::: "memory")
#define PG8_WAIT_L(n) asm volatile("s_waitcnt lgkmcnt(" #n ")" ::: "memory")
#define PG8_BAR __builtin_amdgcn_s_barrier()
#define PG8_SCHED __builtin_amdgcn_sched_barrier(0)
    Unit cur, nxt; int ui = 0;
    if (!S.next(0, cur)) return;
    f32x4 acc[2][2][4][2];
#pragma unroll
    for (int a = 0; a < 2; ++a)
#pragma unroll
        for (int b = 0; b < 2; ++b)
#pragma unroll
            for (int m = 0; m < 4; ++m)
#pragma unroll
                for (int n = 0; n < 2; ++n) acc[a][b][m][n] = (f32x4){0.f, 0.f, 0.f, 0.f};
    bf16x8 At[4][2], B0[2][2], B1[2][2];
    const char* cA = cur.A; const char* cB = cur.B;
    PG8_STAGE(PG8_SB(0, 0), cB, voffB); PG8_STAGE(PG8_SB(0, 1), cB + hstep, voffB); PG8_STAGE(PG8_SA(0, 0), cA, voffA); PG8_STAGE(PG8_SA(0, 1), cA + hstep, voffA);
    if (wr == 1) PG8_BAR;
    PG8_WAIT_V(2); PG8_BAR;
    PG8_STAGE(PG8_SB(1, 0), cB + kstep, voffB); PG8_STAGE(PG8_SA(1, 0), cA + kstep, voffA); PG8_STAGE(PG8_SB(1, 1), cB + hstep + kstep, voffB);
    PG8_WAIT_V(6); PG8_BAR;
    for (;;) {
        const bool has_next = S.next(ui + 1, nxt);
        const char* nA = has_next ? nxt.A : cA; const char* nB = has_next ? nxt.B : cB;
        const int nt = cur.nt;
        for (int t = 0; t < nt; t += 2) {
            const bool last = (t == nt - 2);
            const char* a1 = cA + (size_t)(t + 1) * kstep;
            const char* a2 = last ? nA : cA + (size_t)(t + 2) * kstep; const char* b2 = last ? nB : cB + (size_t)(t + 2) * kstep;
            const char* a3 = a2 + kstep; const char* b3 = b2 + kstep;
            PG8_LDB(B0, 0, 0); PG8_LDB(B1, 0, 1); PG8_SCHED; PG8_LDA(At, 0, 0); PG8_STAGE(PG8_SA(1, 1), a1 + hstep, voffA);
            PG8_WAIT_V(8); PG8_WAIT_L(0); PG8_BAR; PG8_MMA(0, 0, At, B0); PG8_MMA(0, 1, At, B1); PG8_BAR; PG8_SCHED;
            PG8_LDA(At, 0, 1); PG8_STAGE(PG8_SB(0, 0), b2, voffB); PG8_STAGE(PG8_SB(0, 1), b2 + hstep, voffB); PG8_STAGE(PG8_SA(0, 0), a2, voffA);
            PG8_WAIT_V(8); PG8_WAIT_L(0); PG8_BAR; PG8_MMA(1, 0, At, B0); PG8_MMA(1, 1, At, B1); PG8_BAR; PG8_SCHED;
            PG8_LDB(B0, 1, 0); PG8_LDB(B1, 1, 1); PG8_SCHED; PG8_LDA(At, 1, 0); PG8_STAGE(PG8_SA(0, 1), a2 + hstep, voffA);
            PG8_WAIT_V(8); PG8_WAIT_L(0); PG8_BAR; PG8_MMA(0, 0, At, B0); PG8_MMA(0, 1, At, B1); PG8_BAR; PG8_SCHED;
            PG8_LDA(At, 1, 1); PG8_STAGE(PG8_SB(1, 0), b3, voffB); PG8_STAGE(PG8_SB(1, 1), b3 + hstep, voffB); PG8_STAGE(PG8_SA(1, 0), a3, voffA);
            PG8_WAIT_V(8); PG8_WAIT_L(0); PG8_BAR; PG8_MMA(1, 0, At, B0); PG8_MMA(1, 1, At, B1); PG8_BAR; PG8_SCHED;
        }
        if (wr == 0) PG8_BAR;
        E(acc, cur, wr, wc, fr, fq);
        if (!has_next) break;
#pragma unroll
        for (int a = 0; a < 2; ++a)
#pragma unroll
            for (int b = 0; b < 2; ++b)
#pragma unroll
                for (int m = 0; m < 4; ++m)
#pragma unroll
                    for (int n = 0; n < 2; ++n) acc[a][b][m][n] = (f32x4){0.f, 0.f, 0.f, 0.f};
        cur = nxt; cA = nA; cB = nB; ++ui;
        if (wr == 1) PG8_BAR;
    }
    PG8_WAIT_V(0);
    PG8_BAR;
#undef PG8_SA
#undef PG8_SB
#undef PG8_STAGE
#undef PG8_LDA
#undef PG8_LDB
#undef PG8_MMA
#undef PG8_WAIT_V
#undef PG8_WAIT_L
#undef PG8_BAR
#undef PG8_SCHED
}
}

struct Args {
    const float* in[17]; float* out; unsigned char* ws; int ph_lo, ph_hi;
};

__device__ __forceinline__ void phase_mods(LAS unsigned char* lds, const float* c, const float* ada_w, const float* ada_b, float* mods) {
    LAS float* sc = (LAS float*)lds;
    int tid_ = threadIdx.x; asm volatile("" : "+v"(tid_)); const int tid = tid_;
    for (int e = tid; e < 32 * 1024; e += 512) { const int b = e >> 10, k = e & 1023; const float v = c[e]; sc[k * 32 + b] = v * sigmoidf_(v); }
    __syncthreads();
    constexpr int NCOLT = DEPTH * 9216;
    for (int it = blockIdx.x; it < NCOLT / 512; it += (gridDim.x > 144 ? 72 : gridDim.x)) {
        const int n = it * 512 + tid, l = n / 9216, col = n % 9216;
        const float* w = ada_w + (size_t)l * 1024 * 9216 + col;
        float acc[32];
#pragma unroll
        for (int b = 0; b < 32; ++b) acc[b] = 0.f;
#pragma unroll 4
        for (int k = 0; k < 1024; ++k) { const float wv = w[(size_t)k * 9216];
#pragma unroll
            for (int q = 0; q < 8; ++q) { const f32x4 cv = *(const LAS f32x4*)(sc + k * 32 + q * 4); acc[q * 4 + 0] += wv * cv.x; acc[q * 4 + 1] += wv * cv.y; acc[q * 4 + 2] += wv * cv.z; acc[q * 4 + 3] += wv * cv.w; } }
        const float bb = ada_b[l * 9216 + col];
#pragma unroll
        for (int b = 0; b < 32; ++b) mods[((size_t)l * 32 + b) * 9216 + col] = acc[b] + bb;
    }
    __syncthreads();
}

__device__ __forceinline__ int wmap(int mode, int n) {
    if (mode == 0) return n;
    if (mode == 1) return ((n >> 2) << 3) + (n & 3);
    if (mode == 2) return ((n >> 2) << 3) + 4 + (n & 3);
    if (n < 2048) return n;
    if (n < 2072) return C_BG + (n - 2048);
    if (n < 3608) return n - 24;
    return NIN + (n - 3608);
}
__device__ __forceinline__ void tr_item(const float* W, int K, int N, bf16_t* WT, int mode, LAS float* scr, int item, int lane, int ldT = 0) {
    if (ldT == 0) ldT = K;
    const int nblk = (N + 31) / 32, kb = item / nblk, nb = item % nblk, k0 = 64 * kb, n0 = 32 * nb;
    const int qn = n0 + 4 * (lane & 7); const bool ok = qn < N;
#pragma unroll
    for (int i = 0; i < 8; ++i) { const int kk = 8 * i + (lane >> 3); const f32x4 v = ok ? *(const f32x4*)(W + (size_t)(k0 + kk) * N + qn) : (f32x4){0.f, 0.f, 0.f, 0.f};
        LAS float* d = scr + kk * 33 + 4 * (lane & 7); d[0] = v.x; d[1] = v.y; d[2] = v.z; d[3] = v.w; }
    asm volatile("s_waitcnt lgkmcnt(0)" ::: "memory");
    const int c = lane & 7;
#pragma unroll
    for (int j = 0; j < 4; ++j) { const int n = (lane >> 3) + 8 * j; const LAS float* s = scr + (8 * c) * 33 + n;
        u32x4 o; o.x = cvtpk(s[0 * 33], s[1 * 33]); o.y = cvtpk(s[2 * 33], s[3 * 33]); o.z = cvtpk(s[4 * 33], s[5 * 33]); o.w = cvtpk(s[6 * 33], s[7 * 33]);
        if (n0 + n < N) *(u32x4*)(WT + (size_t)wmap(mode, n0 + n) * ldT + k0 + 8 * c) = o; }
    asm volatile("s_waitcnt lgkmcnt(0)" ::: "memory");
}
__device__ __forceinline__ void phase_conv(LAS unsigned char* lds, const Args& a, int l, int wg0, int nwg) {
    int tid_ = threadIdx.x; asm volatile("" : "+v"(tid_));
    const int lane = tid_ & 63, wid = __builtin_amdgcn_readfirstlane(tid_ >> 6), gw = ((int)blockIdx.x - wg0) * 8 + wid, NGW = nwg * 8;
    LAS float* scr = (LAS float*)(lds + wid * 8704);
    bf16_t* Wb = (bf16_t*)(a.ws + WS_W);
    const float* wg = a.in[7] + (size_t)l * 2 * DM * FF; const float* wu = a.in[8] + (size_t)l * 2 * DM * FF; const float* wd = a.in[9] + (size_t)l * 2 * FF * DM;
    const float* win = a.in[10] + (size_t)l * DM * INW; const float* w1 = a.in[13] + (size_t)l * 2 * 2048 * 128; const float* w2 = a.in[14] + (size_t)l * 2 * 128 * 64;
    const float* wb = a.in[15] + (size_t)l * 3 * 512 * DM; const float* wo = a.in[16] + (size_t)l * DM * DM;
    constexpr int I_G = (DM / 64) * (FF / 32), I_D = (FF / 64) * (DM / 32), I_IN = (DM / 64) * ((INW + 31) / 32), I_B = (512 / 64) * (DM / 32), I_O = (DM / 64) * (DM / 32),
                  I_1 = (2048 / 64) * (128 / 32), I_2 = (128 / 64) * (64 / 32);
    constexpr int NITEMS = 4 * I_G + 2 * I_D + I_IN + 3 * I_B + I_O + 2 * I_1 + 2 * I_2;
    for (int it = gw; it < NITEMS; it += NGW) {
        int r = it;
        if (r < 4 * I_G) { const int j = r / (2 * I_G), gu = (r / I_G) & 1; tr_item((gu ? wu : wg) + (size_t)j * DM * FF, DM, FF, Wb + W_GU + (size_t)j * 5632 * DM, 1 + gu, scr, r % I_G, lane); continue; } r -= 4 * I_G;
        if (r < 2 * I_D) { const int j = r / I_D; tr_item(wd + (size_t)j * FF * DM, FF, DM, Wb + W_D + (size_t)j * DM * FF, 0, scr, r % I_D, lane); continue; } r -= 2 * I_D;
        if (r < I_IN) { tr_item(win, DM, INW, Wb + W_IN, 3, scr, r, lane); continue; } r -= I_IN;
        if (r < 3 * I_B) { const int j = r / I_B; tr_item(wb + (size_t)j * 512 * DM, 512, DM, (bf16_t*)(a.ws + WS_WB) + (size_t)j * DM * 1024, 0, scr, r % I_B, lane, 1024); continue; } r -= 3 * I_B;
        if (r < I_O) { tr_item(wo, DM, DM, Wb + W_O, 0, scr, r, lane); continue; } r -= I_O;
        if (r < 2 * I_1) { const int j = r / I_1; tr_item(w1 + (size_t)j * 2048 * 128, 2048, 128, Wb + W_1 + (size_t)j * 128 * 2048, 0, scr, r % I_1, lane); continue; } r -= 2 * I_1;
        { const int j = r / I_2; tr_item(w2 + (size_t)j * 128 * 64, 128, 64, Wb + W_2 + (size_t)j * 64 * 128, 0, scr, r % I_2, lane); }
    }
    { const int tot = (NIN - QP) * DM / 8; for (int e = gw * 64 + lane; e < tot; e += NGW * 64) *(u32x4*)(Wb + W_IN + (size_t)QP * DM + (size_t)e * 8) = (u32x4){0u, 0u, 0u, 0u}; }
    { const float* pos = a.in[12] + (size_t)l * 2 * 2048; float* hb = (float*)(a.ws + WS_HB);
      for (int o = gw; o < 256; o += NGW) { const int ty = o >> 7, hid = o & 127; float s = 0.f;
          for (int k = lane; k < 2048; k += 64) s += pos[ty * 2048 + k] * w1[((size_t)ty * 2048 + k) * 128 + hid];
#pragma unroll
          for (int off = 1; off < 64; off <<= 1) s += __shfl_xor(s, off);
          if (lane == 0) hb[o] = s; } }
}

__device__ __forceinline__ void phase_rowwise(const void* xsrc_, bool sbf, void* xdst_, bool dbf, const bf16_t* Y, bf16_t* H, const float* mods, int lprev, int iprev, const float* lnpost, float resw,
                                              int lnext, int inext, const float* lnpre, bool hasprev, bool hasnext) {
    int tid_ = threadIdx.x; asm volatile("" : "+v"(tid_));
    const int lane = tid_ & 63, wid = __builtin_amdgcn_readfirstlane(tid_ >> 6), gw = blockIdx.x * 8 + wid, NGW = gridDim.x * 8;
    const float* xsrc = (const float*)xsrc_; const bf16_t* xsrcb = (const bf16_t*)xsrc_; float* xdst = (float*)xdst_; bf16_t* xdstb = (bf16_t*)xdst_;
    for (int ch = gw; ch < M / 32; ch += NGW) {
        const int b = ch >> 6;
        f32x4 gp[4], na[4], ns[4];
#pragma unroll
        for (int j = 0; j < 4; ++j) { const int c = 4 * lane + 256 * j;
            if (hasprev) { const f32x4 g = *(const f32x4*)(mods + ((size_t)lprev * 32 + b) * 9216 + iprev * 3072 + 2048 + c); const f32x4 lp = *(const f32x4*)(lnpost + c); gp[j] = g * lp * resw; }
            else gp[j] = (f32x4){0.f, 0.f, 0.f, 0.f};
            if (hasnext) { const f32x4 sh = *(const f32x4*)(mods + ((size_t)lnext * 32 + b) * 9216 + inext * 3072 + c); const f32x4 scl = *(const f32x4*)(mods + ((size_t)lnext * 32 + b) * 9216 + inext * 3072 + 1024 + c);
                const f32x4 lp = *(const f32x4*)(lnpre + c); na[j] = lp * (scl + 1.0f); ns[j] = sh; }
            else { na[j] = (f32x4){0.f, 0.f, 0.f, 0.f}; ns[j] = na[j]; } }
        f32x4 xn[2][4]; u32x2 xnb[2][4]; u32x2 yn[2][4];
        { const size_t m0 = (size_t)ch * 32;
#pragma unroll
          for (int r = 0; r < 2; ++r)
#pragma unroll
            for (int j = 0; j < 4; ++j) { if (sbf) { xnb[r][j] = *(const u32x2*)(xsrcb + (m0 + r) * DM + 4 * lane + 256 * j); xn[r][j] = (f32x4){0.f, 0.f, 0.f, 0.f}; } else { xn[r][j] = *(const f32x4*)(xsrc + (m0 + r) * DM + 4 * lane + 256 * j); xnb[r][j] = (u32x2){0u, 0u}; }
                yn[r][j] = hasprev ? *(const u32x2*)(Y + (m0 + r) * DM + 4 * lane + 256 * j) : (u32x2){0u, 0u}; } }
        for (int rr = 0; rr < 32; rr += 2) {
            const size_t m = (size_t)ch * 32 + rr;
            f32x4 x[2][4]; u32x2 yr[2][4];
#pragma unroll
            for (int r = 0; r < 2; ++r)
#pragma unroll
                for (int j = 0; j < 4; ++j) { if (sbf) { const u32x2 u = xnb[r][j]; x[r][j] = (f32x4){bflo(u.x), bfhi(u.x), bflo(u.y), bfhi(u.y)}; } else x[r][j] = xn[r][j]; yr[r][j] = yn[r][j]; }
            if (rr + 2 < 32) {
#pragma unroll
                for (int r = 0; r < 2; ++r)
#pragma unroll
                    for (int j = 0; j < 4; ++j) { if (sbf) xnb[r][j] = *(const u32x2*)(xsrcb + (m + 2 + r) * DM + 4 * lane + 256 * j); else xn[r][j] = *(const f32x4*)(xsrc + (m + 2 + r) * DM + 4 * lane + 256 * j); if (hasprev) yn[r][j] = *(const u32x2*)(Y + (m + 2 + r) * DM + 4 * lane + 256 * j); } }
            if (hasprev) {
                f32x4 y[2][4]; float ss[2] = {0.f, 0.f};
#pragma unroll
                for (int r = 0; r < 2; ++r)
#pragma unroll
                    for (int j = 0; j < 4; ++j) { const u32x2 u = yr[r][j]; y[r][j] = (f32x4){bflo(u.x), bfhi(u.x), bflo(u.y), bfhi(u.y)};
                        ss[r] += (y[r][j].x * y[r][j].x + y[r][j].y * y[r][j].y) + (y[r][j].z * y[r][j].z + y[r][j].w * y[r][j].w); }
#pragma unroll
                for (int off = 1; off < 64; off <<= 1) { ss[0] += __shfl_xor(ss[0], off); ss[1] += __shfl_xor(ss[1], off); }
#pragma unroll
                for (int r = 0; r < 2; ++r) { const float rs = __builtin_amdgcn_rsqf(ss[r] * (1.f / DM) + EPS);
#pragma unroll
                    for (int j = 0; j < 4; ++j) x[r][j] = x[r][j] + gp[j] * (y[r][j] * rs); }
            }
#pragma unroll
            for (int r = 0; r < 2; ++r)
#pragma unroll
                for (int j = 0; j < 4; ++j) { if (hasprev) { if (dbf) { u32x2 w; w.x = cvtpk(x[r][j].x, x[r][j].y); w.y = cvtpk(x[r][j].z, x[r][j].w); *(u32x2*)(xdstb + (m + r) * DM + 4 * lane + 256 * j) = w; } else *(f32x4*)(xdst + (m + r) * DM + 4 * lane + 256 * j) = x[r][j]; } }
            if (hasnext) {
                float ss[2] = {0.f, 0.f};
#pragma unroll
                for (int r = 0; r < 2; ++r)
#pragma unroll
                    for (int j = 0; j < 4; ++j) ss[r] += (x[r][j].x * x[r][j].x + x[r][j].y * x[r][j].y) + (x[r][j].z * x[r][j].z + x[r][j].w * x[r][j].w);
#pragma unroll
                for (int off = 1; off < 64; off <<= 1) { ss[0] += __shfl_xor(ss[0], off); ss[1] += __shfl_xor(ss[1], off); }
#pragma unroll
                for (int r = 0; r < 2; ++r) { const float rs = __builtin_amdgcn_rsqf(ss[r] * (1.f / DM) + EPS);
#pragma unroll
                    for (int j = 0; j < 4; ++j) { const f32x4 h = (x[r][j] * rs) * na[j] + ns[j]; u32x2 w; w.x = cvtpk(h.x, h.y); w.y = cvtpk(h.z, h.w); *(u32x2*)(H + (m + r) * DM + 4 * lane + 256 * j) = w; } }
            }
        }
    }
}

#define LDS_BARRIER() asm volatile("s_waitcnt lgkmcnt(0)\n\ts_barrier" ::: "memory")
#define MFMA16(a, b, c) __builtin_amdgcn_mfma_f32_16x16x32_bf16((a), (b), (c), 0, 0, 0)
constexpr int KPB = 144;
constexpr int ATT_TILE = 9216, ATT_KS = 0, ATT_VS = 2 * ATT_TILE, ATT_LUT = 4 * ATT_TILE, ATT_FLAG = ATT_LUT + 512;
enum { MODE_A = 0, MODE_BWIN = 1, MODE_BSLC = 2, MODE_C = 3 };
typedef short v4i16_t __attribute__((ext_vector_type(4)));
__device__ __forceinline__ v4i16_t tr_read(const LAS unsigned char* p) { return __builtin_amdgcn_ds_read_tr16_b64_v4i16((LAS v4i16_t*)p); }
__device__ __forceinline__ bf16x8 vfrag(const LAS unsigned char* p) { const v4i16_t a = tr_read(p), b = tr_read(p + 16 * KPB); return (bf16x8){a[0], a[1], a[2], a[3], b[0], b[1], b[2], b[3]}; }

__device__ __forceinline__ void store_row16(bf16_t* rowp, int g, const u32x2 (&pk)[4]) {
    const int par = g & 1;
#pragma unroll
    for (int pr = 0; pr < 2; ++pr) {
        const auto sx = __builtin_amdgcn_permlane16_swap(pk[2 * pr].x, pk[2 * pr + 1].x, false, false);
        const auto sy = __builtin_amdgcn_permlane16_swap(pk[2 * pr].y, pk[2 * pr + 1].y, false, false);
        u32x4 w; w.x = sx[0]; w.y = sy[0]; w.z = sx[1]; w.w = sy[1];
        *(u32x4*)(rowp + 16 * (2 * pr + par) + 4 * (g - par)) = w; }
}

template <int MODE>
__device__ __forceinline__ void attn_pass(LAS unsigned char* lds, const bf16_t* base, int gk, int q0, const float* relb_b, const unsigned* selrow, f32x4 (&o)[2][4]) {
    int tid_ = threadIdx.x; asm volatile("" : "+v"(tid_));
    const int tid = tid_, lane = tid & 63, wid = __builtin_amdgcn_readfirstlane(tid >> 6), c = lane & 15, g = lane >> 4;
    constexpr int W = (MODE == MODE_BWIN) ? 512 : 1 << 20;
    constexpr float LOG2E = 1.4426950408889634f, C1 = 0.125f * LOG2E;
    const int hh = wid & 3, h = gk * 4 + hh;
    const bf16_t* qp = base + C_BQ + h * 64;
    const bf16_t* kp = base + (MODE == MODE_BSLC ? C_BKS : C_BKW) + gk * 64;
    const bf16_t* vp = base + (MODE == MODE_BSLC ? C_BVS : C_BVW) + gk * 64;
    LAS float* lutw = (LAS float*)(lds + ATT_LUT);
    const LAS float* lut = lutw + hh * 128;
    const int qw0 = q0 + (wid >> 2) * 32;
    bf16x8 qf[2][2];
#pragma unroll
    for (int qt = 0; qt < 2; ++qt)
#pragma unroll
        for (int ks = 0; ks < 2; ++ks) qf[qt][ks] = *(const bf16x8*)(qp + (size_t)(qw0 + qt * 16 + c) * QP + ks * 32 + g * 8);
    const int kb_hi = q0 >> 6;
    unsigned todo;
    unsigned sel[2] = {0xffffffffu, 0xffffffffu};
    unsigned selw = 0xffffffffu;
    if (MODE == MODE_BSLC) {
        sel[0] = selrow[qw0 + c]; sel[1] = selrow[qw0 + 16 + c];
        unsigned u = sel[0] | sel[1];
#pragma unroll
        for (int off = 1; off < 64; off <<= 1) u |= __shfl_xor(u, off);
        selw = __builtin_amdgcn_readfirstlane(u);
        unsigned v = selrow[q0 + lane];
#pragma unroll
        for (int off = 1; off < 64; off <<= 1) v |= __shfl_xor(v, off);
        todo = __builtin_amdgcn_readfirstlane(v) & (0xffffffffu >> (31 - kb_hi));
    } else {
        const int kb_lo = kb_hi >= 8 ? kb_hi - 8 : 0;
        todo = (0xffffffffu >> (31 - kb_hi)) & (0xffffffffu << kb_lo);
    }
    __syncthreads();
    if (tid < 512) { const int e = tid; lutw[e] = relb_b[(int)T5B[e & 127] * 16 + gk * 4 + (e >> 7)] * LOG2E; }
    const float bias_far = relb_b[31 * 16 + h] * LOG2E;
#pragma unroll
    for (int qt = 0; qt < 2; ++qt)
#pragma unroll
        for (int dt = 0; dt < 4; ++dt) o[qt][dt] = (f32x4){0.f, 0.f, 0.f, 0.f};
    float mrun[2] = {-1e30f, -1e30f}, lrun[2] = {0.f, 0.f};
    const int skey = tid >> 3, sch = tid & 7;
    const unsigned soff = skey * KPB + sch * 16;
    u32x4 kreg, vreg;
    int kb = 31 - __builtin_clz(todo); todo &= ~(1u << kb);
    { const size_t ro = (size_t)(kb * 64 + skey) * QP + sch * 8; kreg = *(const u32x4*)(kp + ro); vreg = *(const u32x4*)(vp + ro); }
    *(LAS u32x4*)(lds + ATT_KS + soff) = kreg; *(LAS u32x4*)(lds + ATT_VS + soff) = vreg;
    int kbn = todo ? 31 - __builtin_clz(todo) : -1; if (kbn >= 0) todo &= ~(1u << kbn);
    if (kbn >= 0) { const size_t ro = (size_t)(kbn * 64 + skey) * QP + sch * 8; kreg = *(const u32x4*)(kp + ro); vreg = *(const u32x4*)(vp + ro); }
    LDS_BARRIER();
    int buf = 0;
    while (kb >= 0) {
        const int kbnn = todo ? 31 - __builtin_clz(todo) : -1; if (kbnn >= 0) todo &= ~(1u << kbnn);
        if (kbn >= 0) { *(LAS u32x4*)(lds + ATT_KS + (buf ^ 1) * ATT_TILE + soff) = kreg; *(LAS u32x4*)(lds + ATT_VS + (buf ^ 1) * ATT_TILE + soff) = vreg; }
        if (kbnn >= 0) { const size_t ro = (size_t)(kbnn * 64 + skey) * QP + sch * 8; kreg = *(const u32x4*)(kp + ro); vreg = *(const u32x4*)(vp + ro); }
        const LAS unsigned char* Ks = lds + ATT_KS + buf * ATT_TILE; const LAS unsigned char* Vs = lds + ATT_VS + buf * ATT_TILE;
        const int k0 = kb * 64;
        const bool need = (MODE == MODE_BSLC) ? (((selw >> kb) & 1u) != 0u) : true;
        if (need) {
        bf16x8 kfr[4][2], vfr[4][2];
#pragma unroll
        for (int nt = 0; nt < 4; ++nt) { kfr[nt][0] = *(const LAS bf16x8*)(Ks + (16 * nt + c) * KPB + g * 16); kfr[nt][1] = *(const LAS bf16x8*)(Ks + (16 * nt + c) * KPB + 64 + g * 16); }
        { const LAS unsigned char* vb = Vs + (4 * g + (c >> 2)) * KPB + (c & 3) * 8;
#pragma unroll
          for (int dt = 0; dt < 4; ++dt)
#pragma unroll
            for (int p = 0; p < 2; ++p) vfr[dt][p] = vfrag(vb + 32 * p * KPB + dt * 32); }
        __builtin_amdgcn_sched_barrier(0);
        f32x4 s[2][4];
#pragma unroll
        for (int nt = 0; nt < 4; ++nt) {
#pragma unroll
            for (int qt = 0; qt < 2; ++qt) { f32x4 z = (f32x4){0.f, 0.f, 0.f, 0.f}; z = MFMA16(kfr[nt][0], qf[qt][0], z); s[qt][nt] = MFMA16(kfr[nt][1], qf[qt][1], z); }
        }
        const bool far = (qw0 - (k0 + 63)) >= 113;
        const bool fast = far && ((qw0 + 31 - k0) < W);
#pragma unroll
        for (int qt = 0; qt < 2; ++qt) {
            const bool selb = (MODE == MODE_BSLC) ? (((sel[qt] >> kb) & 1u) != 0u) : true;
            float mnew, alpha;
            if (fast) {
                float mx = fmaxf(fmaxf(s[qt][0][0], s[qt][0][1]), fmaxf(s[qt][0][2], s[qt][0][3]));
#pragma unroll
                for (int nt = 1; nt < 4; ++nt) mx = fmaxf(mx, fmaxf(fmaxf(s[qt][nt][0], s[qt][nt][1]), fmaxf(s[qt][nt][2], s[qt][nt][3])));
                mx = fmaxf(mx, __shfl_xor(mx, 16)); mx = fmaxf(mx, __shfl_xor(mx, 32));
                const float mxl = selb ? (mx * C1 + bias_far) : -1e30f;
                mnew = fmaxf(mrun[qt], mxl); alpha = __builtin_amdgcn_exp2f(mrun[qt] - mnew);
                const float c1 = selb ? C1 : 0.f, c2 = selb ? (bias_far - mnew) : -1e30f;
#pragma unroll
                for (int nt = 0; nt < 4; ++nt)
#pragma unroll
                    for (int j = 0; j < 4; ++j) s[qt][nt][j] = __builtin_amdgcn_exp2f(s[qt][nt][j] * c1 + c2);
            } else {
                const int dbase = selb ? (qw0 + 16 * qt + c - k0 - 4 * g) : -(1 << 22);
                float mx = -1e30f;
#pragma unroll
                for (int nt = 0; nt < 4; ++nt)
#pragma unroll
                    for (int j = 0; j < 4; ++j) { const int dist = dbase - (16 * nt + j); const bool valid = (unsigned)dist < (unsigned)W;
                        const unsigned di = (unsigned)dist < 127u ? (unsigned)dist : 127u;
                        const float lg = valid ? (s[qt][nt][j] * C1 + lut[di]) : -1e30f; s[qt][nt][j] = lg; mx = fmaxf(mx, lg); }
                mx = fmaxf(mx, __shfl_xor(mx, 16)); mx = fmaxf(mx, __shfl_xor(mx, 32));
                mnew = fmaxf(mrun[qt], mx); alpha = __builtin_amdgcn_exp2f(mrun[qt] - mnew);
#pragma unroll
                for (int nt = 0; nt < 4; ++nt)
#pragma unroll
                    for (int j = 0; j < 4; ++j) s[qt][nt][j] = __builtin_amdgcn_exp2f(s[qt][nt][j] - mnew);
            }
            float ps = 0.f;
#pragma unroll
            for (int nt = 0; nt < 4; ++nt) ps += (s[qt][nt][0] + s[qt][nt][1]) + (s[qt][nt][2] + s[qt][nt][3]);
            lrun[qt] = lrun[qt] * alpha + ps;
            if (__any(mnew > mrun[qt])) {
#pragma unroll
                for (int dt = 0; dt < 4; ++dt) o[qt][dt] = o[qt][dt] * alpha; }
            mrun[qt] = mnew;
        }
        bf16x8 pb[2][2];
#pragma unroll
        for (int qt = 0; qt < 2; ++qt)
#pragma unroll
            for (int p = 0; p < 2; ++p) { u32x4 w; w.x = cvtpk(s[qt][2 * p][0], s[qt][2 * p][1]); w.y = cvtpk(s[qt][2 * p][2], s[qt][2 * p][3]);
                w.z = cvtpk(s[qt][2 * p + 1][0], s[qt][2 * p + 1][1]); w.w = cvtpk(s[qt][2 * p + 1][2], s[qt][2 * p + 1][3]); pb[qt][p] = __builtin_bit_cast(bf16x8, w); }
#pragma unroll
        for (int dt = 0; dt < 4; ++dt)
#pragma unroll
            for (int p = 0; p < 2; ++p) {
#pragma unroll
                for (int qt = 0; qt < 2; ++qt) o[qt][dt] = MFMA16(vfr[dt][p], pb[qt][p], o[qt][dt]); }
        }
        LDS_BARRIER();
        kb = kbn; kbn = kbnn; buf ^= 1;
    }
#pragma unroll
    for (int qt = 0; qt < 2; ++qt) { float l = lrun[qt]; l += __shfl_xor(l, 16); l += __shfl_xor(l, 32);
        const float inv = 1.f / l;
#pragma unroll
        for (int dt = 0; dt < 4; ++dt) o[qt][dt] = o[qt][dt] * inv; }
}

constexpr int AW_VT = 0, AW_LUT = 8 * ATT_TILE;
template <int MODE>
__device__ __forceinline__ void attn_wave(LAS unsigned char* lds, const bf16_t* qkv, bf16_t* Yout, const float* sinks, int wi) {
    int tid_ = threadIdx.x; asm volatile("" : "+v"(tid_));
    const int lane = tid_ & 63, wid = __builtin_amdgcn_readfirstlane(tid_ >> 6), c = lane & 15, g = lane >> 4;
    constexpr float LOG2E = 1.4426950408889634f, C1 = 0.125f * LOG2E;
    constexpr int NQT = 4;
    const int qb = wi & 31, h = (wi >> 5) & 7, b = wi >> 8; const int q0 = qb * 64;
    const bf16_t* base = qkv + (size_t)b * SEQ * QP;
    const bf16_t* qp = base + (MODE == MODE_A ? C_AQ + h * 64 : C_CQ + h * 64);
    const bf16_t* kp = base + (MODE == MODE_A ? C_AK + (h >> 2) * 64 : C_CK + h * 64);
    const bf16_t* vp = base + (MODE == MODE_A ? C_AV + (h >> 2) * 64 : C_CV + h * 64);
    LAS unsigned char* Vs = lds + AW_VT + wid * ATT_TILE;
    const LAS float* lutp = (const LAS float*)(lds + AW_LUT) + h * 128;
    bf16x8 qf[NQT][2];
#pragma unroll
    for (int qt = 0; qt < NQT; ++qt)
#pragma unroll
        for (int ks = 0; ks < 2; ++ks) qf[qt][ks] = *(const bf16x8*)(qp + (size_t)(q0 + qt * 16 + c) * QP + ks * 32 + g * 8);
    f32x4 o[NQT][4];
#pragma unroll
    for (int qt = 0; qt < NQT; ++qt)
#pragma unroll
        for (int dt = 0; dt < 4; ++dt) o[qt][dt] = (f32x4){0.f, 0.f, 0.f, 0.f};
    float mrun[NQT], lrun[NQT], carry[NQT];
#pragma unroll
    for (int qt = 0; qt < NQT; ++qt) { mrun[qt] = -1e30f; lrun[qt] = 0.f; carry[qt] = 0.f; }
    const int kb_hi = (q0 + 63) >> 5;
    int kb_lo = 0;
    if (MODE == MODE_A) { const int lo = q0 - 127; kb_lo = lo > 0 ? (lo >> 5) : 0; }
    for (int kb = kb_hi; kb >= kb_lo; --kb) {
        const int k0 = kb * 32;
        u32x4 vr[4];
#pragma unroll
        for (int i = 0; i < 4; ++i) { const int e = lane + 64 * i; vr[i] = *(const u32x4*)(vp + (size_t)(k0 + (e >> 3)) * QP + (e & 7) * 8); }
        bf16x8 kf[2][2];
#pragma unroll
        for (int nt = 0; nt < 2; ++nt)
#pragma unroll
            for (int ks = 0; ks < 2; ++ks) kf[nt][ks] = *(const bf16x8*)(kp + (size_t)(k0 + 16 * nt + c) * QP + ks * 32 + g * 8);
#pragma unroll
        for (int i = 0; i < 4; ++i) { const int e = lane + 64 * i; *(LAS u32x4*)(Vs + (e >> 3) * KPB + (e & 7) * 16) = vr[i]; }
        bf16x8 vfr[4];
        { const LAS unsigned char* vb = Vs + (4 * g + (c >> 2)) * KPB + (c & 3) * 8;
#pragma unroll
          for (int dt = 0; dt < 4; ++dt) vfr[dt] = vfrag(vb + dt * 32); }
        __builtin_amdgcn_sched_barrier(0);
#pragma unroll
        for (int qt = 0; qt < NQT; ++qt) {
            bool live = (k0 <= q0 + 16 * qt + 15);
            if (MODE == MODE_A) live = live && (q0 + 16 * qt - (k0 + 31) < 128);
            if (MODE == MODE_C) { const bool dq = __all(carry[qt] < -150.1f); live = live && !dq; }
            if (!live) continue;
            f32x4 s[2];
#pragma unroll
            for (int nt = 0; nt < 2; ++nt) { f32x4 z = (f32x4){0.f, 0.f, 0.f, 0.f}; z = MFMA16(kf[nt][0], qf[qt][0], z); s[nt] = MFMA16(kf[nt][1], qf[qt][1], z); }
            const int dbase = q0 + 16 * qt + c - k0 - 4 * g;
            if (MODE == MODE_A) {
                float mx = -1e30f;
#pragma unroll
                for (int nt = 0; nt < 2; ++nt)
#pragma unroll
                    for (int j = 0; j < 4; ++j) { const int dist = dbase - (16 * nt + j); const bool valid = (unsigned)dist < 128u;
                        const float bias2 = lutp[dist & 127];
                        const float lg = valid ? (s[nt][j] * C1 + bias2) : -1e30f; s[nt][j] = lg; mx = fmaxf(mx, lg); }
                mx = fmaxf(mx, __shfl_xor(mx, 16)); mx = fmaxf(mx, __shfl_xor(mx, 32));
                const float mnew = fmaxf(mrun[qt], mx); const float alpha = __builtin_amdgcn_exp2f(mrun[qt] - mnew); mrun[qt] = mnew;
                float ps = 0.f;
#pragma unroll
                for (int nt = 0; nt < 2; ++nt)
#pragma unroll
                    for (int j = 0; j < 4; ++j) { const float p = __builtin_amdgcn_exp2f(s[nt][j] - mnew); s[nt][j] = p; ps += p; }
                lrun[qt] = lrun[qt] * alpha + ps;
#pragma unroll
                for (int dt = 0; dt < 4; ++dt) o[qt][dt] = o[qt][dt] * alpha;
            } else {
                float lk[2][4], c4[2];
#pragma unroll
                for (int nt = 0; nt < 2; ++nt) { c4[nt] = 0.f;
#pragma unroll
                    for (int j = 0; j < 4; ++j) { const bool valid = (dbase - (16 * nt + j)) > 0; const float z = s[nt][j] * C1;
                        const float e = __builtin_amdgcn_exp2f(-fabsf(z));
                        const float sp = fmaxf(z, 0.f) + __builtin_amdgcn_logf(1.f + e);
                        lk[nt][j] = valid ? -sp : 0.f; s[nt][j] = valid ? (z - sp) : -1e30f; c4[nt] += lk[nt][j]; } }
                float after = 0.f;
#pragma unroll
                for (int nt = 1; nt >= 0; --nt) {
                    const float v1 = __shfl_xor(c4[nt], 16), v2 = __shfl_xor(c4[nt], 32), v3 = __shfl_xor(c4[nt], 48);
                    const float G = (((g ^ 1) > g) ? v1 : 0.f) + (((g ^ 2) > g) ? v2 : 0.f) + (((g ^ 3) > g) ? v3 : 0.f);
                    const float T = c4[nt] + v1 + v2 + v3;
                    float sfx = carry[qt] + after + G;
#pragma unroll
                    for (int j = 3; j >= 0; --j) { const float w = __builtin_amdgcn_exp2f(s[nt][j] + sfx); s[nt][j] = w; sfx += lk[nt][j]; }
                    after += T;
                }
                carry[qt] += after;
            }
            u32x4 w; w.x = cvtpk(s[0][0], s[0][1]); w.y = cvtpk(s[0][2], s[0][3]); w.z = cvtpk(s[1][0], s[1][1]); w.w = cvtpk(s[1][2], s[1][3]);
            const bf16x8 pb = __builtin_bit_cast(bf16x8, w);
#pragma unroll
            for (int dt = 0; dt < 4; ++dt) o[qt][dt] = MFMA16(vfr[dt], pb, o[qt][dt]);
        }
        if (MODE == MODE_C) {
            bool dn = (k0 <= q0);
#pragma unroll
            for (int qt = 0; qt < NQT; ++qt) dn = dn && (carry[qt] < -150.1f);
            if (__all(dn)) break;
        }
    }
    if (MODE == MODE_A) {
        const float sk2 = sinks[h] * LOG2E;
#pragma unroll
        for (int qt = 0; qt < NQT; ++qt) { float l = lrun[qt]; l += __shfl_xor(l, 16); l += __shfl_xor(l, 32);
            l += __builtin_amdgcn_exp2f(sk2 - mrun[qt]);
            const float inv = 1.f / l;
#pragma unroll
            for (int dt = 0; dt < 4; ++dt) o[qt][dt] = o[qt][dt] * inv; }
    }
#pragma unroll
    for (int qt = 0; qt < NQT; ++qt) { const size_t row = (size_t)b * SEQ + q0 + qt * 16 + c;
        u32x2 pk[4];
#pragma unroll
        for (int dt = 0; dt < 4; ++dt) { pk[dt].x = cvtpk(o[qt][dt][0], o[qt][dt][1]); pk[dt].y = cvtpk(o[qt][dt][2], o[qt][dt][3]); }
        store_row16(Yout + row * YP + h * 64, g, pk); }
}

template <int MODE>
__device__ __forceinline__ void attn_pass128(LAS unsigned char* lds, const bf16_t* qkv, int b, int gk, int q0, const float* relb_b, const unsigned* selrow,
                                             const bf16_t* addsrc, int addpitch, bf16_t* Yb) {
    int tid_ = threadIdx.x; asm volatile("" : "+v"(tid_));
    const int tid = tid_, lane = tid & 63, wid = __builtin_amdgcn_readfirstlane(tid >> 6), c = lane & 15, g = lane >> 4;
    constexpr int W = (MODE == MODE_BWIN) ? 512 : 1 << 20;
    constexpr float LOG2E = 1.4426950408889634f, C1 = 0.125f * LOG2E;
    constexpr int NQT = 4;
    const bf16_t* base = qkv + (size_t)b * SEQ * QP;
    const int hh = wid & 3, h = gk * 4 + hh;
    const bf16_t* qp = base + C_BQ + h * 64;
    const bf16_t* kp = base + (MODE == MODE_BSLC ? C_BKS : C_BKW) + gk * 64;
    const bf16_t* vp = base + (MODE == MODE_BSLC ? C_BVS : C_BVW) + gk * 64;
    LAS float* lutw = (LAS float*)(lds + ATT_LUT);
    const LAS float* lut = lutw + hh * 128;
    const int qw0 = q0 + (wid >> 2) * 64;
    bf16x8 qf[NQT][2];
#pragma unroll
    for (int qt = 0; qt < NQT; ++qt)
#pragma unroll
        for (int ks = 0; ks < 2; ++ks) qf[qt][ks] = *(const bf16x8*)(qp + (size_t)(qw0 + qt * 16 + c) * QP + ks * 32 + g * 8);
    const int kb_hi = (q0 + 127) >> 6;
    unsigned todo;
    unsigned sel[NQT] = {0xffffffffu, 0xffffffffu, 0xffffffffu, 0xffffffffu};
    unsigned selq[NQT] = {0xffffffffu, 0xffffffffu, 0xffffffffu, 0xffffffffu};
    if (MODE == MODE_BSLC) {
#pragma unroll
        for (int qt = 0; qt < NQT; ++qt) { sel[qt] = selrow[qw0 + 16 * qt + c]; unsigned u = sel[qt];
#pragma unroll
            for (int off = 1; off < 64; off <<= 1) u |= __shfl_xor(u, off);
            selq[qt] = __builtin_amdgcn_readfirstlane(u); }
        unsigned v = selrow[q0 + lane] | selrow[q0 + 64 + lane];
#pragma unroll
        for (int off = 1; off < 64; off <<= 1) v |= __shfl_xor(v, off);
        todo = __builtin_amdgcn_readfirstlane(v) & (0xffffffffu >> (31 - kb_hi));
    } else {
        const int lo = q0 - 511; const int kb_lo = lo > 0 ? (lo >> 6) : 0;
        todo = (0xffffffffu >> (31 - kb_hi)) & (0xffffffffu << kb_lo);
    }
    __syncthreads();
    if (tid < 512) { const int e = tid; lutw[e] = relb_b[(int)T5B[e & 127] * 16 + gk * 4 + (e >> 7)] * LOG2E; }
    const float bias_far = relb_b[31 * 16 + h] * LOG2E;
    f32x4 o[NQT][4];
    float mrun[NQT], lrun[NQT];
#pragma unroll
    for (int qt = 0; qt < NQT; ++qt) { mrun[qt] = -1e30f; lrun[qt] = 0.f;
#pragma unroll
        for (int dt = 0; dt < 4; ++dt) o[qt][dt] = (f32x4){0.f, 0.f, 0.f, 0.f}; }
    const int skey = tid >> 3, sch = tid & 7;
    const unsigned soff = skey * KPB + sch * 16;
    u32x4 kreg, vreg;
    int kb = 31 - __builtin_clz(todo); todo &= ~(1u << kb);
    { const size_t ro = (size_t)(kb * 64 + skey) * QP + sch * 8; kreg = *(const u32x4*)(kp + ro); vreg = *(const u32x4*)(vp + ro); }
    *(LAS u32x4*)(lds + ATT_KS + soff) = kreg; *(LAS u32x4*)(lds + ATT_VS + soff) = vreg;
    int kbn = todo ? 31 - __builtin_clz(todo) : -1; if (kbn >= 0) todo &= ~(1u << kbn);
    if (kbn >= 0) { const size_t ro = (size_t)(kbn * 64 + skey) * QP + sch * 8; kreg = *(const u32x4*)(kp + ro); vreg = *(const u32x4*)(vp + ro); }
    LDS_BARRIER();
    int buf = 0;
    while (kb >= 0) {
        const int kbnn = todo ? 31 - __builtin_clz(todo) : -1; if (kbnn >= 0) todo &= ~(1u << kbnn);
        if (kbn >= 0) { *(LAS u32x4*)(lds + ATT_KS + (buf ^ 1) * ATT_TILE + soff) = kreg; *(LAS u32x4*)(lds + ATT_VS + (buf ^ 1) * ATT_TILE + soff) = vreg; }
        if (kbnn >= 0) { const size_t ro = (size_t)(kbnn * 64 + skey) * QP + sch * 8; kreg = *(const u32x4*)(kp + ro); vreg = *(const u32x4*)(vp + ro); }
        const LAS unsigned char* Ks = lds + ATT_KS + buf * ATT_TILE; const LAS unsigned char* Vs = lds + ATT_VS + buf * ATT_TILE;
        const int k0 = kb * 64;
        bool lv[NQT]; bool need = false;
#pragma unroll
        for (int qt = 0; qt < NQT; ++qt) { bool l_ = (k0 <= qw0 + 16 * qt + 15) && ((qw0 + 16 * qt - (k0 + 63)) < W);
            if (MODE == MODE_BSLC) l_ = l_ && (((selq[qt] >> kb) & 1u) != 0u);
            lv[qt] = l_; need = need || l_; }
        if (need) {
        bf16x8 kfr[4][2], vfr[4][2];
#pragma unroll
        for (int nt = 0; nt < 4; ++nt) { kfr[nt][0] = *(const LAS bf16x8*)(Ks + (16 * nt + c) * KPB + g * 16); kfr[nt][1] = *(const LAS bf16x8*)(Ks + (16 * nt + c) * KPB + 64 + g * 16); }
        { const LAS unsigned char* vb = Vs + (4 * g + (c >> 2)) * KPB + (c & 3) * 8;
#pragma unroll
          for (int dt = 0; dt < 4; ++dt)
#pragma unroll
            for (int p = 0; p < 2; ++p) vfr[dt][p] = vfrag(vb + 32 * p * KPB + dt * 32); }
        __builtin_amdgcn_sched_barrier(0);
#pragma unroll
        for (int qt = 0; qt < NQT; ++qt) {
            if (!lv[qt]) continue;
            const int tq0 = qw0 + 16 * qt;
            f32x4 s[4];
#pragma unroll
            for (int nt = 0; nt < 4; ++nt) { f32x4 z = (f32x4){0.f, 0.f, 0.f, 0.f}; z = MFMA16(kfr[nt][0], qf[qt][0], z); s[nt] = MFMA16(kfr[nt][1], qf[qt][1], z); }
            const bool far = (tq0 - (k0 + 63)) >= 113;
            const bool fast = far && ((tq0 + 15 - k0) < W);
            const bool selb = (MODE == MODE_BSLC) ? (((sel[qt] >> kb) & 1u) != 0u) : true;
            float mnew, alpha;
            if (fast) {
                float mx = fmaxf(fmaxf(s[0][0], s[0][1]), fmaxf(s[0][2], s[0][3]));
#pragma unroll
                for (int nt = 1; nt < 4; ++nt) mx = fmaxf(mx, fmaxf(fmaxf(s[nt][0], s[nt][1]), fmaxf(s[nt][2], s[nt][3])));
                mx = fmaxf(mx, __shfl_xor(mx, 16)); mx = fmaxf(mx, __shfl_xor(mx, 32));
                const float mxl = selb ? (mx * C1 + bias_far) : -1e30f;
                mnew = fmaxf(mrun[qt], mxl); alpha = __builtin_amdgcn_exp2f(mrun[qt] - mnew);
                const float c1 = selb ? C1 : 0.f, c2 = selb ? (bias_far - mnew) : -1e30f;
#pragma unroll
                for (int nt = 0; nt < 4; ++nt)
#pragma unroll
                    for (int j = 0; j < 4; ++j) s[nt][j] = __builtin_amdgcn_exp2f(s[nt][j] * c1 + c2);
            } else {
                const int dbase = selb ? (tq0 + c - k0 - 4 * g) : -(1 << 22);
                float mx = -1e30f;
#pragma unroll
                for (int nt = 0; nt < 4; ++nt)
#pragma unroll
                    for (int j = 0; j < 4; ++j) { const int dist = dbase - (16 * nt + j); const bool valid = (unsigned)dist < (unsigned)W;
                        const unsigned di = (unsigned)dist < 127u ? (unsigned)dist : 127u;
                        const float lg = valid ? (s[nt][j] * C1 + lut[di]) : -1e30f; s[nt][j] = lg; mx = fmaxf(mx, lg); }
                mx = fmaxf(mx, __shfl_xor(mx, 16)); mx = fmaxf(mx, __shfl_xor(mx, 32));
                mnew = fmaxf(mrun[qt], mx); alpha = __builtin_amdgcn_exp2f(mrun[qt] - mnew);
#pragma unroll
                for (int nt = 0; nt < 4; ++nt)
#pragma unroll
                    for (int j = 0; j < 4; ++j) s[nt][j] = __builtin_amdgcn_exp2f(s[nt][j] - mnew);
            }
            float ps = 0.f;
#pragma unroll
            for (int nt = 0; nt < 4; ++nt) ps += (s[nt][0] + s[nt][1]) + (s[nt][2] + s[nt][3]);
            lrun[qt] = lrun[qt] * alpha + ps;
            if (__any(mnew > mrun[qt])) {
#pragma unroll
                for (int dt = 0; dt < 4; ++dt) o[qt][dt] = o[qt][dt] * alpha; }
            mrun[qt] = mnew;
            bf16x8 pb[2];
#pragma unroll
            for (int p = 0; p < 2; ++p) { u32x4 w; w.x = cvtpk(s[2 * p][0], s[2 * p][1]); w.y = cvtpk(s[2 * p][2], s[2 * p][3]);
                w.z = cvtpk(s[2 * p + 1][0], s[2 * p + 1][1]); w.w = cvtpk(s[2 * p + 1][2], s[2 * p + 1][3]); pb[p] = __builtin_bit_cast(bf16x8, w); }
#pragma unroll
            for (int dt = 0; dt < 4; ++dt)
#pragma unroll
                for (int p = 0; p < 2; ++p) o[qt][dt] = MFMA16(vfr[dt][p], pb[p], o[qt][dt]);
        }
        }
        LDS_BARRIER();
        kb = kbn; kbn = kbnn; buf ^= 1;
    }
    const int par = g & 1; const int gidx = (MODE == MODE_BSLC) ? 8 : 16;
#pragma unroll
    for (int qt = 0; qt < NQT; ++qt) { float l = lrun[qt]; l += __shfl_xor(l, 16); l += __shfl_xor(l, 32);
        const size_t row = (size_t)b * SEQ + qw0 + qt * 16 + c;
        const float sc = sigmoidf_(bf2f(qkv[row * QP + C_BG + gidx + h])) / l;
#pragma unroll
        for (int pr = 0; pr < 2; ++pr) {
            const f32x4 ra = o[qt][2 * pr] * sc, rb = o[qt][2 * pr + 1] * sc;
            float lo[4], hi[4];
#pragma unroll
            for (int e = 0; e < 4; ++e) { const auto sw = __builtin_amdgcn_permlane16_swap(__float_as_uint(ra[e]), __float_as_uint(rb[e]), false, false); lo[e] = __uint_as_float(sw[0]); hi[e] = __uint_as_float(sw[1]); }
            const int dofs = h * 64 + 16 * (2 * pr + par) + 4 * (g - par);
            const u32x4 old = *(const u32x4*)(addsrc + row * addpitch + dofs);
            u32x4 w; w.x = cvtpk(lo[0] + bflo(old.x), lo[1] + bfhi(old.x)); w.y = cvtpk(lo[2] + bflo(old.y), lo[3] + bfhi(old.y));
            w.z = cvtpk(hi[0] + bflo(old.z), hi[1] + bfhi(old.z)); w.w = cvtpk(hi[2] + bflo(old.w), hi[3] + bfhi(old.w));
            *(u32x4*)(Yb + row * YP + dofs) = w; } }
}
__device__ __forceinline__ void item_attn_b128(LAS unsigned char* lds, const bf16_t* qkv, bf16_t* Yb, const bf16_t* Ycmp, const float* relb, const unsigned* selm, int it) {
    const int t128 = 15 - (it >> 6), gk = it & 1, b = (it >> 1) & 31; const int q0 = t128 * 128;
    attn_pass128<MODE_BSLC>(lds, qkv, b, gk, q0, relb + 8, selm + ((size_t)b * 2 + gk) * SEQ, Ycmp, 512, Yb);
    attn_pass128<MODE_BWIN>(lds, qkv, b, gk, q0, relb + 8, nullptr, Yb, YP, Yb);
}

__device__ __forceinline__ void item_attn_b(LAS unsigned char* lds, const bf16_t* qkv, bf16_t* Yb, const bf16_t* Ycmp, const float* relb, const unsigned* selm, int it) {
    const int t64 = 31 - (it >> 6), gk = it & 1, b = (it >> 1) & 31; const int q0 = t64 * 64; const bf16_t* base = qkv + (size_t)b * SEQ * QP;
    int tid_ = threadIdx.x; asm volatile("" : "+v"(tid_));
    const int lane = tid_ & 63, wid = tid_ >> 6, c = lane & 15, g = lane >> 4;
    const int h = gk * 4 + (wid & 3), qw0 = q0 + (wid >> 2) * 32;
    f32x4 o1[2][4], o2[2][4];
    attn_pass<MODE_BSLC>(lds, base, gk, q0, relb + 8, selm + ((size_t)b * 2 + gk) * SEQ, o1);
    attn_pass<MODE_BWIN>(lds, base, gk, q0, relb + 8, nullptr, o2);
#pragma unroll
    for (int qt = 0; qt < 2; ++qt) { const size_t row = (size_t)b * SEQ + qw0 + qt * 16 + c;
        const float g1 = sigmoidf_(bf2f(qkv[row * QP + C_BG + 8 + h])), g2 = sigmoidf_(bf2f(qkv[row * QP + C_BG + 16 + h]));
        const int par = g & 1;
#pragma unroll
        for (int pr = 0; pr < 2; ++pr) {
            const f32x4 ra = o1[qt][2 * pr] * g1 + o2[qt][2 * pr] * g2, rb = o1[qt][2 * pr + 1] * g1 + o2[qt][2 * pr + 1] * g2;
            float lo[4], hi[4];
#pragma unroll
            for (int e = 0; e < 4; ++e) { const auto sw = __builtin_amdgcn_permlane16_swap(__float_as_uint(ra[e]), __float_as_uint(rb[e]), false, false); lo[e] = __uint_as_float(sw[0]); hi[e] = __uint_as_float(sw[1]); }
            const int dofs = h * 64 + 16 * (2 * pr + par) + 4 * (g - par);
            const u32x4 old = *(const u32x4*)(Ycmp + row * 512 + dofs);
            u32x4 w; w.x = cvtpk(lo[0] + bflo(old.x), lo[1] + bfhi(old.x)); w.y = cvtpk(lo[2] + bflo(old.y), lo[3] + bfhi(old.y));
            w.z = cvtpk(hi[0] + bflo(old.z), hi[1] + bfhi(old.z)); w.w = cvtpk(hi[2] + bflo(old.w), hi[3] + bfhi(old.w));
            *(u32x4*)(Yb + row * YP + dofs) = w; } }
}

__device__ __forceinline__ void item_cmpk(const bf16_t* qkv, const bf16_t* Wb, const float* hb, bf16_t* KC, int it, int wsub) {
    int tid_ = threadIdx.x; asm volatile("" : "+v"(tid_));
    const int lane = tid_ & 63, wid = wsub, c = lane & 15, g = lane >> 4;
    const int ty = it & 1, gk = (it >> 1) & 1, b = it >> 2;
    const int n = 16 * wid + c, nn = n < 127 ? n : 126;
    const bf16_t* src = qkv + ((size_t)b * SEQ + 16 * nn) * QP + (ty ? C_BVC : C_BKC) + gk * 64 + g * 8;
    const bf16_t* w1t = Wb + W_1 + (size_t)ty * 128 * 2048 + (size_t)c * 2048 + g * 8;
    f32x4 hT[8];
#pragma unroll
    for (int ht = 0; ht < 8; ++ht) hT[ht] = (f32x4){0.f, 0.f, 0.f, 0.f};
#pragma unroll 2
    for (int ks = 0; ks < 64; ++ks) {
        const bf16x8 bfrag = *(const bf16x8*)(src + (size_t)(ks >> 1) * QP + (ks & 1) * 32);
#pragma unroll
        for (int ht = 0; ht < 8; ++ht) { const bf16x8 afrag = *(const bf16x8*)(w1t + (size_t)ht * 16 * 2048 + ks * 32); hT[ht] = MFMA16(afrag, bfrag, hT[ht]); }
    }
#pragma unroll
    for (int ht = 0; ht < 8; ++ht)
#pragma unroll
        for (int j = 0; j < 4; ++j) { const float x = hT[ht][j] + hb[ty * 128 + 16 * ht + 4 * g + j]; const float u = 0.7978845608028654f * (x + 0.044715f * x * x * x);
            const float th = 1.f - 2.f * fast_rcp(1.f + __expf(2.f * u)); hT[ht][j] = 0.5f * x * (1.f + th); }
    f32x4 oT[4];
#pragma unroll
    for (int dt = 0; dt < 4; ++dt) oT[dt] = (f32x4){0.f, 0.f, 0.f, 0.f};
    const bf16_t* w2t = Wb + W_2 + (size_t)ty * 64 * 128;
#pragma unroll
    for (int p = 0; p < 4; ++p) { u32x4 w; w.x = cvtpk(hT[2 * p][0], hT[2 * p][1]); w.y = cvtpk(hT[2 * p][2], hT[2 * p][3]); w.z = cvtpk(hT[2 * p + 1][0], hT[2 * p + 1][1]); w.w = cvtpk(hT[2 * p + 1][2], hT[2 * p + 1][3]);
        const bf16x8 bfrag = __builtin_bit_cast(bf16x8, w);
#pragma unroll
        for (int dt = 0; dt < 4; ++dt) { const bf16_t* ap = w2t + (size_t)(16 * dt + c) * 128 + 32 * p + 4 * g; const u32x2 a0 = *(const u32x2*)ap, a1 = *(const u32x2*)(ap + 16);
            u32x4 aw; aw.x = a0.x; aw.y = a0.y; aw.z = a1.x; aw.w = a1.y; oT[dt] = MFMA16(__builtin_bit_cast(bf16x8, aw), bfrag, oT[dt]); } }
    if (n < 127) { bf16_t* dst = KC + ((((size_t)ty * 32 + b) * 2 + gk) * 128 + n) * 64;
#pragma unroll
        for (int dt = 0; dt < 4; ++dt) { u32x2 w; w.x = cvtpk(oT[dt][0], oT[dt][1]); w.y = cvtpk(oT[dt][2], oT[dt][3]); *(u32x2*)(dst + 16 * dt + 4 * g) = w; } }
}

constexpr int CMP_KS = 0, CMP_KPB = 144, CMP_VT = 128 * 144, CMP_VPB = 272, CMP_IMP = 36864;
__device__ __forceinline__ void item_attn_cmp(LAS unsigned char* lds, const bf16_t* qkv, const bf16_t* KC, bf16_t* Yb, unsigned* selm, int it) {
    int tid_ = threadIdx.x; asm volatile("" : "+v"(tid_));
    const int tid = tid_, lane = tid & 63, wid = tid >> 6, c = lane & 15, g = lane >> 4;
    const int q16 = it & 15, gk = (it >> 4) & 1, b = it >> 5; const int q0 = q16 * 128;
    LAS unsigned char* Ks = lds + CMP_KS; LAS unsigned char* Vt = lds + CMP_VT;
    const bf16_t* kc = KC + (((size_t)0 * 32 + b) * 2 + gk) * 128 * 64; const bf16_t* vc = KC + (((size_t)1 * 32 + b) * 2 + gk) * 128 * 64;
    __syncthreads();
#pragma unroll
    for (int r = 0; r < 2; ++r) { const int e = tid + 512 * r; const int key = e >> 3, ch = e & 7;
        u32x4 kv = (u32x4){0u, 0u, 0u, 0u}, vv = kv;
        if (key < 127) { kv = *(const u32x4*)(kc + key * 64 + ch * 8); vv = *(const u32x4*)(vc + key * 64 + ch * 8); }
        *(LAS u32x4*)(Ks + key * CMP_KPB + ch * 16) = kv; *(LAS u32x4*)(Vt + key * CMP_KPB + ch * 16) = vv; }
    __syncthreads();
    const int t = q0 + wid * 16 + c; const size_t row = (size_t)b * SEQ + t;
    float psum[8][4];
#pragma unroll
    for (int nt = 0; nt < 8; ++nt)
#pragma unroll
        for (int j = 0; j < 4; ++j) psum[nt][j] = 0.f;
#pragma unroll 1
    for (int hh = 0; hh < 4; ++hh) {
        const int h = gk * 4 + hh;
        const bf16x8 qf0 = *(const bf16x8*)(qkv + row * QP + C_BQ + h * 64 + g * 8), qf1 = *(const bf16x8*)(qkv + row * QP + C_BQ + h * 64 + 32 + g * 8);
        f32x4 s[8]; float mx = -1e30f;
#pragma unroll
        for (int nt = 0; nt < 8; ++nt) { const bf16x8 kf0 = *(const LAS bf16x8*)(Ks + (16 * nt + c) * CMP_KPB + g * 16), kf1 = *(const LAS bf16x8*)(Ks + (16 * nt + c) * CMP_KPB + 64 + g * 16);
            f32x4 z = (f32x4){0.f, 0.f, 0.f, 0.f}; z = MFMA16(kf0, qf0, z); z = MFMA16(kf1, qf1, z);
#pragma unroll
            for (int j = 0; j < 4; ++j) { const int n = 16 * nt + 4 * g + j; const bool valid = (16 * n + 31) <= t; const float lg = valid ? z[j] * 0.125f : -1e30f; z[j] = lg; mx = fmaxf(mx, lg); }
            s[nt] = z; }
        mx = fmaxf(mx, __shfl_xor(mx, 16)); mx = fmaxf(mx, __shfl_xor(mx, 32));
        float sum = 0.f;
#pragma unroll
        for (int nt = 0; nt < 8; ++nt)
#pragma unroll
            for (int j = 0; j < 4; ++j) { const float lg = s[nt][j]; const float e = (lg > -1e29f) ? __expf(lg - mx) : 0.f; s[nt][j] = e; sum += e; }
        sum += __shfl_xor(sum, 16); sum += __shfl_xor(sum, 32);
        const float inv = sum > 0.f ? 1.f / sum : 0.f;
#pragma unroll
        for (int nt = 0; nt < 8; ++nt)
#pragma unroll
            for (int j = 0; j < 4; ++j) { const float p = s[nt][j] * inv; s[nt][j] = p; psum[nt][j] += p; }
        f32x4 o[4];
#pragma unroll
        for (int dt = 0; dt < 4; ++dt) o[dt] = (f32x4){0.f, 0.f, 0.f, 0.f};
#pragma unroll
        for (int p = 0; p < 4; ++p) { u32x4 w; w.x = cvtpk(s[2 * p][0], s[2 * p][1]); w.y = cvtpk(s[2 * p][2], s[2 * p][3]); w.z = cvtpk(s[2 * p + 1][0], s[2 * p + 1][1]); w.w = cvtpk(s[2 * p + 1][2], s[2 * p + 1][3]);
            const bf16x8 pbf = __builtin_bit_cast(bf16x8, w);
#pragma unroll
            for (int dt = 0; dt < 4; ++dt) { const bf16x8 vf = vfrag(Vt + (32 * p + 4 * g + (c >> 2)) * CMP_KPB + dt * 32 + (c & 3) * 8); o[dt] = MFMA16(vf, pbf, o[dt]); } }
        const float g0 = sigmoidf_(bf2f(qkv[row * QP + C_BG + h]));
        { u32x2 pk[4];
#pragma unroll
          for (int dt = 0; dt < 4; ++dt) { pk[dt].x = cvtpk(o[dt][0] * g0, o[dt][1] * g0); pk[dt].y = cvtpk(o[dt][2] * g0, o[dt][3] * g0); }
          store_row16(Yb + row * 512 + h * 64, g, pk); }
    }
    float imp[8], sh3[8];
#pragma unroll
    for (int nt = 0; nt < 8; ++nt) sh3[nt] = __shfl(psum[nt][3], (lane + 48) & 63);
#pragma unroll
    for (int nt = 0; nt < 8; ++nt) { const float prev = (g > 0) ? sh3[nt] : (nt > 0 ? sh3[nt > 0 ? nt - 1 : 0] : 0.f); imp[nt] = (psum[nt][0] + psum[nt][1]) + (psum[nt][2] + psum[nt][3]) + prev; }
    const int cur = t >> 6; const int nforced = cur >= 2 ? 3 : cur + 1; const int nfree = 16 - nforced;
    LAS float* impl = (LAS float*)(lds + CMP_IMP) + (wid * 16 + c) * 33;
#pragma unroll
    for (int nt = 0; nt < 8; ++nt) impl[4 * nt + g] = imp[nt];
    asm volatile("s_waitcnt lgkmcnt(0)" ::: "memory");
    int rank[8];
#pragma unroll
    for (int nt = 0; nt < 8; ++nt) rank[nt] = 0;
#pragma unroll 1
    for (int jb2 = 1; jb2 <= cur - 2; ++jb2) {
        const float v = impl[jb2];
#pragma unroll
        for (int nt = 0; nt < 8; ++nt) { const int jb = 4 * nt + g; rank[nt] += ((v > imp[nt]) || (v == imp[nt] && jb2 < jb)) ? 1 : 0; }
    }
    unsigned bits = 0u;
#pragma unroll
    for (int nt = 0; nt < 8; ++nt) { const int jb = 4 * nt + g; const bool forced = (jb == 0) || (jb == cur) || (jb == cur - 1); const bool cand = (jb >= 1) && (jb <= cur - 2);
        if (forced || (cand && rank[nt] < nfree)) bits |= (1u << jb); }
    bits |= __shfl_xor(bits, 16); bits |= __shfl_xor(bits, 32);
    if (g == 0) selm[((size_t)b * 2 + gk) * SEQ + t] = bits;
}


#define XB_TMO      128
#define XB_XCNT(j)  (256  + 64 * (j))
#define XB_XSUB(j)  (1280 + 64 * (j))
#define XB_XGEN(j)  (2304 + 64 * (j))
#define XB_TOP      3328
#define XB_TOPGEN   3392
#define XCD_BAR_WORDS 3456
#define XB_SPIN_CAP (1u << 22)
__device__ __forceinline__ unsigned xb_ld(unsigned* p)              { return __hip_atomic_load(p, __ATOMIC_RELAXED, __HIP_MEMORY_SCOPE_AGENT); }
__device__ __forceinline__ unsigned xb_add(unsigned* p, unsigned v) { return __hip_atomic_fetch_add(p, v, __ATOMIC_RELAXED, __HIP_MEMORY_SCOPE_AGENT); }
__device__ __forceinline__ unsigned xb_xcc_id() { return (unsigned)__builtin_amdgcn_s_getreg((3 << 11) | 20) & 0xFu; }
#define XB_SPIN(cond, bar) do { unsigned _sp = 0; while (cond) { __builtin_amdgcn_s_sleep(1); \
    if ((++_sp & 255u) == 0u) { if (xb_ld(&(bar)[XB_TMO])) break; if (_sp > XB_SPIN_CAP) { atomicAdd(&(bar)[XB_TMO], 1u); break; } } } } while (0)
struct XcdBarrier { unsigned* bar; unsigned x; volatile LAS unsigned* st; };
__device__ __forceinline__ XcdBarrier xcd_barrier_post(unsigned* bar, volatile LAS unsigned* st) {
    XcdBarrier b; b.bar = bar; b.x = xb_xcc_id(); b.st = st;
    if (threadIdx.x == 0) (void)xb_add(&bar[XB_XCNT(b.x)], 1u);
    return b;
}
__device__ __forceinline__ void xcd_barrier_complete(unsigned* bar, unsigned x, unsigned& nloc, unsigned& nx) {
    const unsigned G = gridDim.x * gridDim.y * gridDim.z;
    unsigned sum, cnt, mine, sp = 0u;
    for (;;) {
        sum = 0u; cnt = 0u; mine = 0u;
#pragma unroll
        for (unsigned j = 0; j < 16; ++j) { const unsigned c = xb_ld(&bar[XB_XCNT(j)]); sum += c; cnt += (c > 0u) ? 1u : 0u; mine = (j == x) ? c : mine; }
        if (sum == G) break;
        __builtin_amdgcn_s_sleep(1);
        if ((++sp & 255u) == 0u) { if (xb_ld(&bar[XB_TMO])) break; if (sp > XB_SPIN_CAP) { atomicAdd(&bar[XB_TMO], 1u); break; } }
    }
    nloc = mine > 0u ? mine : 1u; nx = cnt > 0u ? cnt : 1u;
}
__device__ __forceinline__ void xcd_barrier(const XcdBarrier& b) {
    asm volatile("s_waitcnt vmcnt(0)" ::: "memory");
    __syncthreads();
    if (threadIdx.x == 0) {
        unsigned* bar = b.bar;
        __builtin_amdgcn_s_waitcnt(0);
        unsigned nloc = b.st[0], nx = b.st[1];
        if (nloc == 0u) { xcd_barrier_complete(bar, b.x, nloc, nx); b.st[0] = nloc; b.st[1] = nx; }
        const unsigned old = xb_add(&bar[XB_XSUB(b.x)], 1u);
        const unsigned gen = old / nloc;
        if (old + 1u == (gen + 1u) * nloc) {
            __builtin_amdgcn_fence(__ATOMIC_RELEASE, "agent");
            asm volatile("s_waitcnt vmcnt(0)" ::: "memory");
            const unsigned og = xb_add(&bar[XB_TOP], 1u);
            const unsigned tg = og / nx;
            if (og + 1u == (tg + 1u) * nx) xb_add(&bar[XB_TOPGEN], 1u);
            else XB_SPIN(xb_ld(&bar[XB_TOPGEN]) == tg, bar);
            __builtin_amdgcn_fence(__ATOMIC_ACQUIRE, "agent");
            xb_add(&bar[XB_XGEN(b.x)], 1u);
            asm volatile("s_waitcnt vmcnt(0)" ::: "memory");
        } else {
            XB_SPIN(xb_ld(&bar[XB_XGEN(b.x)]) == gen, bar);
            __builtin_amdgcn_fence(__ATOMIC_ACQUIRE, "agent");
            asm volatile("s_waitcnt vmcnt(0)" ::: "memory");
        }
    }
    __syncthreads();
}

constexpr int NPHASES = 2 + DEPTH * 13;

__global__ void __launch_bounds__(512, 2) mega_fwd(Args a) {
    extern __shared__ __attribute__((aligned(16))) unsigned char lds_raw[];
    LAS unsigned char* lds = (LAS unsigned char*)lds_raw;
    cg::grid_group grid = cg::this_grid();
    volatile LAS unsigned* bst = (volatile LAS unsigned*)(lds + LDS_BYTES - 16);
    if (threadIdx.x < 4) bst[threadIdx.x] = 0u;
    __syncthreads();
    const XcdBarrier xbar = xcd_barrier_post((unsigned*)a.ws + 1024, bst);
    const int G = gridDim.x;
    const int lo = a.ph_lo, hi = a.ph_hi;
    unsigned char* ws = a.ws;
    float* mods = (float*)(ws + WS_MOD); bf16_t* KC = (bf16_t*)(ws + WS_KC); unsigned* selm = (unsigned*)(ws + WS_SEL); const float* hb = (const float*)(ws + WS_HB);
    bf16_t* Wb = (bf16_t*)(ws + WS_W); bf16_t* H = (bf16_t*)(ws + WS_H); bf16_t* BIG = (bf16_t*)(ws + WS_BIG); bf16_t* Y = (bf16_t*)(ws + WS_Y);
    bf16_t* Ya = Y; bf16_t* Yb = Y + 512; bf16_t* Yc = Y + (size_t)M * YP; bf16_t* Ycmp = (bf16_t*)(ws + WS_YCMP); bf16_t* WbT = (bf16_t*)(ws + WS_WB); bf16_t* MG = BIG + (size_t)64 * MiB / 2;
    const float* x_in = a.in[0]; const float* relb = a.in[2]; const float* ln_pre = a.in[5]; const float* ln_post = a.in[6];
    enum { K_MODS, K_INIT, K_G1, K_G2, K_ROW, K_GIN, K_ATT1, K_CMP, K_ATTB, K_FUSED, K_OUT };
    for (int ph = lo; ph < hi; ++ph) {
        int kind, l = 0, i = 0;
        if (ph == 0) kind = K_MODS; else if (ph == 1) kind = K_INIT;
        else { const int r = ph - 2; l = r / 13; const int q = r - 13 * l;
            if (q < 3) { i = 0; kind = q == 0 ? K_G1 : q == 1 ? K_G2 : K_ROW; }
            else if (q < 10) { i = 1; kind = q == 3 ? K_GIN : q == 4 ? K_ATT1 : q == 5 ? K_CMP : q == 6 ? K_ATTB : q == 7 ? K_FUSED : q == 8 ? K_OUT : K_ROW; }
            else { i = 2; kind = q == 10 ? K_G1 : q == 11 ? K_G2 : K_ROW; } }
        const int nrep = NREP(kind);
        for (int rep = 0; rep < nrep; ++rep) {
        if (rep) xcd_barrier(xbar);
        if (kind == K_G1 || kind == K_G2 || kind == K_GIN || kind == K_FUSED || kind == K_OUT) {
            const int j = i >> 1;
            pg8::Gemm g; pg8::EpiGen E; pg8::StaticOrder S_;
            E.sG = BIG + (size_t)blockIdx.x * 131072; E.sM = E.sG + 65536;
            const bf16_t* Ag; const bf16_t* Bg; int Nn, Kk;
            if (kind == K_G1) { Ag = H; Bg = Wb + W_GU + (size_t)j * 5632 * DM; Nn = 5632; Kk = DM; S_.em = 2; E.O = BIG; E.ldc = FF; E.ncols = 5632; }
            else if (kind == K_G2) { Ag = BIG; Bg = Wb + W_D + (size_t)j * DM * FF; Nn = DM; Kk = FF; S_.em = 0; E.O = Y; E.ldc = DM; E.ncols = DM; }
            else if (kind == K_GIN) { Ag = H; Bg = Wb + W_IN; Nn = NIN; Kk = DM; S_.em = 0; E.O = BIG; E.ldc = QP; E.ncols = QP; }
            else if (kind == K_FUSED) { Ag = H; Bg = Wb + W_IN + (size_t)NIN * DM; Nn = DM; Kk = DM; S_.em = 5; E.O = MG; E.ldc = DM; E.ncols = DM; }
            else { Ag = MG; Bg = Wb + W_O; Nn = DM; Kk = DM; S_.em = 0; E.O = Y; E.ldc = DM; E.ncols = DM; }
            g.ld = Kk;
            S_.init(M, Nn, G, (int)blockIdx.x);
            S_.A = (const char*)Ag; S_.B = (const char*)Bg; S_.tstep = (size_t)256 * Kk * 2; S_.nt = Kk / 64;
            S_.fused = (kind == K_FUSED) ? 1 : 0;
            S_.Hh = (const char*)H; S_.Wmg = (const char*)(Wb + W_IN + (size_t)NIN * DM); S_.Yab = (const char*)Y; S_.Yc = (const char*)Yc; S_.WbT = (const char*)WbT;
            { int tq_ = threadIdx.x; asm volatile("" : "+v"(tq_)); pg8::utab_build(lds, S_, tq_); }
            pg8::TabSched T_{lds};
            pg8::gemm_phase<pg8::EpiGen>(lds, g, T_, E);
        } else if (kind == K_MODS) {
            if (G > 144) { if ((int)blockIdx.x < 72) phase_mods(lds, a.in[1], a.in[3], a.in[4], mods); else phase_conv(lds, a, 0, 72, G - 72); }
            else { phase_mods(lds, a.in[1], a.in[3], a.in[4], mods); phase_conv(lds, a, 0, 0, G); }
        } else if (kind == K_INIT || kind == K_ROW) {
            const bool init = (kind == K_INIT);
            const bool last = (!init && l == DEPTH - 1 && i == 2);
            const int ln_ = init ? 0 : (i == 2 ? l + 1 : l), in_ = init ? 0 : (i == 2 ? 0 : i + 1);
            if (!init && i == 2 && !last) phase_conv(lds, a, l + 1, 0, G);
            const bool first = init || (l == 0 && i == 0), l3i1 = (!init && l == DEPTH - 1 && i == 1);
            const void* xs_ = first ? (const void*)x_in : last ? (const void*)Yc : (const void*)a.out;
            void* xd_ = l3i1 ? (void*)Yc : (void*)a.out;
            phase_rowwise(xs_, !first, xd_, !last, Y, H, mods, l, i, ln_post + ((size_t)l * 3 + i) * DM, i == 1 ? 1.0f : 0.5f, last ? 0 : ln_, in_, ln_pre + ((size_t)(last ? 0 : ln_) * 3 + in_) * DM, !init, !last);
        } else if (kind == K_ATT1) {
            {
                LAS float* lt = (LAS float*)(lds + AW_LUT);
                int t0_ = threadIdx.x; asm volatile("" : "+v"(t0_));
                for (int e = t0_; e < 8 * 128; e += 512) lt[e] = relb[(int)T5B[e & 127] * 16 + (e >> 7)] * 1.4426950408889634f;
                __syncthreads();
            }
            int t1_ = threadIdx.x; asm volatile("" : "+v"(t1_));
            const int wv = blockIdx.x * 8 + __builtin_amdgcn_readfirstlane(t1_ >> 6), NWV = G * 8;
            (void)wv; (void)NWV;
            unsigned* qctr = (unsigned*)a.ws + 8192 + ph;
            for (;;) {
                unsigned v_ = 0u; if ((t1_ & 63) == 0) v_ = atomicAdd(qctr, 1u);
                const int it = (int)__builtin_amdgcn_readfirstlane(v_);
                if (it >= 1024 + 8192 + 8192) break;
                if (it < 1024) item_cmpk(BIG, Wb, hb, KC, it >> 3, it & 7);
                else if (it < 1024 + 8192) attn_wave<MODE_C>(lds, BIG, Yc, nullptr, it - 1024);
                else attn_wave<MODE_A>(lds, BIG, Ya, a.in[11] + l * 8, it - 1024 - 8192);
            }
        } else if (kind == K_CMP) {
            for (int it = blockIdx.x; it < 1024; it += G) item_attn_cmp(lds, BIG, KC, Ycmp, selm, it);
        } else {
            unsigned* qctr = (unsigned*)a.ws + 8192 + ph;
            volatile LAS unsigned* qslot = (volatile LAS unsigned*)(lds + LDS_BYTES - 32);
            for (;;) {
                __syncthreads();
                if (threadIdx.x == 0) qslot[0] = atomicAdd(qctr, 1u);
                __syncthreads();
                const int it = (int)qslot[0];
                if (it >= 1024) break;
                item_attn_b128(lds, BIG, Yb, Ycmp, relb, selm, it);
            }
        }
        __syncthreads();
        }
        if (ph + 1 < hi) { if (ph == 0) grid.sync(); else xcd_barrier(xbar); }
    }
}

extern "C" void kernel_launch(void* const* d_in, const int* in_sizes, int n_in, void* d_out, int out_size, void* d_ws, size_t ws_size, hipStream_t stream) {
    static int grid = 0;
    if (grid == 0) {
        if (n_in != 17 || in_sizes[0] != M * DM || out_size != M * DM || ws_size < WS_END) { fprintf(stderr, "kernel_launch: unexpected shapes / workspace (n_in %d ws %zu)\n", n_in, ws_size); grid = -1; return; }
        int dev = 0, cus = 0, per_cu = 0;
        (void)hipGetDevice(&dev); (void)hipDeviceGetAttribute(&cus, hipDeviceAttributeMultiprocessorCount, dev);
        (void)hipFuncSetAttribute((const void*)mega_fwd, hipFuncAttributeMaxDynamicSharedMemorySize, LDS_BYTES);
        (void)hipOccupancyMaxActiveBlocksPerMultiprocessor(&per_cu, (const void*)mega_fwd, 512, LDS_BYTES);
        if (per_cu < 1) per_cu = 1;
        grid = cus * per_cu;
        (void)hipGetLastError();
    }
    if (grid < 0) return;
    if (hipMemsetAsync(d_ws, 0, 65536, stream) != hipSuccess) { fprintf(stderr, "kernel_launch: memset of barrier words failed\n"); return; }
    Args a{};
    for (int i = 0; i < 17; ++i) a.in[i] = (const float*)d_in[i];
    a.out = (float*)d_out; a.ws = (unsigned char*)d_ws;
#if MK_PER_PHASE_LAUNCH
    for (int p = 0; p < NPHASES; ++p) { a.ph_lo = p; a.ph_hi = p + 1; hipLaunchKernelGGL(mega_fwd, dim3(grid), dim3(512), LDS_BYTES, stream, a); }
#else
    a.ph_lo = 0; a.ph_hi = NPHASES;
    void* args[] = {&a};
    hipError_t e = hipLaunchCooperativeKernel((const void*)mega_fwd, dim3(grid), dim3(512), args, LDS_BYTES, stream);
    if (e != hipSuccess) fprintf(stderr, "cooperative launch failed: %s (grid %d)\n", hipGetErrorString(e), grid);
#endif
}
```

```cpp
#include <hip/hip_runtime.h>
#include <hip/hip_cooperative_groups.h>
#include <cstdio>
#include <cstdint>
namespace cg = cooperative_groups;

#ifndef MK_PER_PHASE_LAUNCH
#define MK_PER_PHASE_LAUNCH 0
#endif

#ifndef PHMASK
#define PHMASK 0xFFFF
#endif
#define PHON(k) ((PHMASK >> (k)) & 1)
#ifndef REPMASK
#define REPMASK 0
#endif
#define NREP(k) (1 + ((REPMASK >> (k)) & 1))
#define LAS __attribute__((address_space(3)))
typedef unsigned short bf16_t;
typedef short bf16x8 __attribute__((ext_vector_type(8)));
typedef float f32x4 __attribute__((ext_vector_type(4)));
typedef float f32x2 __attribute__((ext_vector_type(2)));
typedef unsigned u32x4 __attribute__((ext_vector_type(4)));
typedef unsigned u32x2 __attribute__((ext_vector_type(2)));
typedef __bf16 bf16x2_t __attribute__((ext_vector_type(2)));

constexpr int BATCH = 32, SEQ = 2048, DM = 1024, M = BATCH * SEQ, DEPTH = 4, FF = 2816;
constexpr int INW = 6680;
constexpr int QP = 3608;
constexpr int NIN = 3840;
constexpr int NMG = 3072;
constexpr float EPS = 1e-6f;
constexpr int C_AQ = 0, C_AK = 512, C_AV = 640, C_BQ = 768, C_BKC = 1280, C_BVC = 1408, C_BKS = 1536, C_BVS = 1664, C_BKW = 1792, C_BVW = 1920,
              C_CQ = 2048, C_CK = 2560, C_CV = 3072, C_BG = 3584;
constexpr size_t MiB = 1u << 20;
constexpr size_t WS_MOD = 1 * MiB;
constexpr size_t WS_KC = 6 * MiB;
constexpr size_t WS_SEL = 8 * MiB;
constexpr size_t WS_HB = 9 * MiB;
constexpr size_t WS_W = 10 * MiB;
constexpr size_t WS_H = 64 * MiB;
constexpr size_t WS_BIG = 192 * MiB;
constexpr size_t WS_Y = 644 * MiB;
constexpr size_t WS_YCMP = 900 * MiB;
constexpr size_t WS_WB = 964 * MiB;
constexpr size_t WS_END = 970 * MiB;
constexpr int YP = 1024;
constexpr size_t W_GU = 0, W_D = 11534336, W_IN = 17301504, W_B = 24379392, W_O = 25952256, W_1 = 27000832, W_2 = 27525120;

constexpr int LDS_BYTES = 147456;

__device__ __constant__ unsigned char T5B[128] = {0, 1, 2, 3, 4, 5, 6, 7, 8, 9, 10, 11, 12, 13, 14, 15, 16, 16, 16, 17, 17, 18, 18, 18, 19, 19, 19, 20, 20, 20, 20, 21, 21, 21, 21, 22, 22, 22, 22, 22, 23, 23, 23, 23, 23, 23, 24, 24, 24, 24, 24, 24, 25, 25, 25, 25, 25, 25, 25, 26, 26, 26, 26, 26, 26, 26, 26, 27, 27, 27, 27, 27, 27, 27, 27, 27, 27, 28, 28, 28, 28, 28, 28, 28, 28, 28, 28, 29, 29, 29, 29, 29, 29, 29, 29, 29, 29, 29, 29, 30, 30, 30, 30, 30, 30, 30, 30, 30, 30, 30, 30, 30, 30, 31, 31, 31, 31, 31, 31, 31, 31, 31, 31, 31, 31, 31, 31, 31};

__device__ __forceinline__ unsigned cvtpk(float lo, float hi) { f32x2 v = {lo, hi}; bf16x2_t b = __builtin_convertvector(v, bf16x2_t); return __builtin_bit_cast(unsigned, b); }
__device__ __forceinline__ float bf2f(unsigned short u) { return __uint_as_float((unsigned)u << 16); }
__device__ __forceinline__ float bflo(unsigned u) { return __uint_as_float(u << 16); }
__device__ __forceinline__ float bfhi(unsigned u) { return __uint_as_float(u & 0xffff0000u); }
__device__ __forceinline__ float fast_rcp(float x) { return __builtin_amdgcn_rcpf(x); }
__device__ __forceinline__ float sigmoidf_(float x) { return fast_rcp(1.f + __expf(-x)); }

namespace pg8 {
constexpr int BM = 256, BK = 64, HALF = 128, HTB = HALF * BK * 2, STAGE_BYTES = 8 * HTB, NXCD = 8, WGM = 8;
__host__ __device__ __forceinline__ int lds_byte(int r, int c) { const int st = (r >> 4) * 2 + (c >> 5), rr = r & 15, cc = c & 31, ob = rr * 64 + cc * 2; return st * 1024 + (ob ^ (((ob >> 9) & 1) << 5)); }
__host__ __device__ __forceinline__ void stage_rc(int b, int& R, int& C) { const int st = b / 1024, sb = b % 1024, swz = sb ^ (((sb >> 9) & 1) << 5); R = (st >> 1) * 16 + swz / 64; C = (st & 1) * 32 + (swz % 64) / 2; }
__host__ __device__ __forceinline__ int perm32(int rho) { const int n = rho >> 4, i = rho & 15; return 8 * (i >> 2) + 4 * n + (i & 3); }
struct Unit { const char* A; const char* B; int nt; int pm, pn; int em, br; };
struct Gemm { int ld; };
struct StaticOrder {
    int nM, nN, nwg, G, c; int fused; const char* A; const char* B; size_t tstep; int nt; int em;
    const char* Hh; const char* Wmg; const char* Yab; const char* Yc; const char* WbT;
    __device__ void init(int M_, int N_, int G_, int c_) { nM = M_ / BM; nN = N_ / BM; nwg = nM * nN; G = G_; c = c_; fused = 0; }
    __device__ __forceinline__ bool tile(long L, int& pm, int& pn) const {
        if (L >= nwg) return false;
        int wgid = (int)L; { const int q = nwg / NXCD, r = nwg % NXCD, xcd = wgid % NXCD, off = wgid / NXCD; wgid = (xcd < r ? xcd * (q + 1) : r * (q + 1) + (xcd - r) * q) + off; }
        const int nig = WGM * nN, gid = wgid / nig, fm = gid * WGM, gsz = (nM - fm) < WGM ? (nM - fm) : WGM;
        pm = fm + ((wgid % nig) % gsz); pn = (wgid % nig) / gsz; return true;
    }
    __device__ __forceinline__ bool next(int i, Unit& u) const {
        if (!fused) {
            if (!tile((long)i * G + c, u.pm, u.pn)) return false;
            u.A = A + (size_t)u.pm * tstep; u.B = B + (size_t)u.pn * tstep; u.nt = nt; u.em = em; u.br = 0; return true;
        }
        const int t = i / 6, sub = i - 6 * t;
        if (!tile((long)t * G + c, u.pm, u.pn)) return false;
        const int br = sub >> 1; u.br = br;
        if ((sub & 1) == 0) { u.A = Hh + (size_t)u.pm * tstep; u.B = Wmg + (size_t)(br * 4 + u.pn) * tstep; u.nt = 16; u.em = 5; }
        else { u.A = (br == 0 ? Yab : br == 1 ? Yab + 512 * 2 : Yc) + (size_t)u.pm * tstep; u.B = WbT + (size_t)(br * 4 + u.pn) * tstep; u.nt = 8; u.em = 6; }
        return true;
    }
};
struct EpiGen {
    bf16_t* O; int ldc; int ncols; bf16_t* sG; bf16_t* sM;
    __device__ __forceinline__ void operator()(const f32x4 (&acc)[2][2][4][2], const Unit& u, int wr, int wc, int fr, int fq) const {
        const int mode = u.em;
        int fr_ = fr; asm volatile("" : "+v"(fr_));
        const int rl0 = wr * 64 + fr_, cl0 = wc * 32 + 8 * fq;
        if (mode == 2) {
            const int par = fq & 1;
#pragma unroll
            for (int ai = 0; ai < 2; ++ai)
#pragma unroll
                for (int bj = 0; bj < 2; ++bj) { const int acol = ((u.pn * BM + bj * HALF + wc * 32) >> 1) + 4 * (fq - par);
#pragma unroll
                    for (int mp = 0; mp < 4; mp += 2) {
                        u32x2 wk[2];
#pragma unroll
                        for (int q = 0; q < 2; ++q) { const f32x4 v0 = acc[ai][bj][mp + q][0], v1 = acc[ai][bj][mp + q][1]; float r[4];
#pragma unroll
                            for (int e = 0; e < 4; ++e) r[e] = v0[e] * sigmoidf_(v0[e]) * v1[e];
                            wk[q].x = cvtpk(r[0], r[1]); wk[q].y = cvtpk(r[2], r[3]); }
                        const auto sx = __builtin_amdgcn_permlane16_swap(wk[0].x, wk[1].x, false, false);
                        const auto sy = __builtin_amdgcn_permlane16_swap(wk[0].y, wk[1].y, false, false);
                        u32x4 w; w.x = sx[0]; w.y = sy[0]; w.z = sx[1]; w.w = sy[1];
                        const size_t row = (size_t)(u.pm * BM + rl0 + ai * HALF + (mp + par) * 16);
                        *(u32x4*)(O + row * ldc + acol) = w; } }
            return;
        }
#pragma unroll
        for (int ai = 0; ai < 2; ++ai)
#pragma unroll
            for (int m = 0; m < 4; ++m) { const int rl = rl0 + ai * HALF + m * 16; const size_t row = (size_t)(u.pm * BM + rl); bf16_t* rowp = O + row * ldc;
#pragma unroll
                for (int bj = 0; bj < 2; ++bj) { const int cl = cl0 + bj * HALF; const int col0 = u.pn * BM + cl; f32x4 v0 = acc[ai][bj][m][0], v1 = acc[ai][bj][m][1];
                    if (mode == 2) {
                        float r[4];
#pragma unroll
                        for (int e = 0; e < 4; ++e) r[e] = v0[e] * sigmoidf_(v0[e]) * v1[e];
                        u32x2 w; w.x = cvtpk(r[0], r[1]); w.y = cvtpk(r[2], r[3]);
                        *(u32x2*)(rowp + (col0 >> 1)) = w;
                    } else {
                        if (mode == 1 || mode == 5) {
#pragma unroll
                            for (int e = 0; e < 4; ++e) { v0[e] = sigmoidf_(v0[e]); v1[e] = sigmoidf_(v1[e]); } }
                        if (mode == 6) {
                            const u32x4 gq = *(const u32x4*)(sG + rl * 256 + cl);
                            v0[0] *= bflo(gq.x); v0[1] *= bfhi(gq.x); v0[2] *= bflo(gq.y); v0[3] *= bfhi(gq.y); v1[0] *= bflo(gq.z); v1[1] *= bfhi(gq.z); v1[2] *= bflo(gq.w); v1[3] *= bfhi(gq.w);
                            if (u.br > 0) { const u32x4 mo = *(const u32x4*)(sM + rl * 256 + cl);
                                v0[0] += bflo(mo.x); v0[1] += bfhi(mo.x); v0[2] += bflo(mo.y); v0[3] += bfhi(mo.y); v1[0] += bflo(mo.z); v1[1] += bfhi(mo.z); v1[2] += bflo(mo.w); v1[3] += bfhi(mo.w); } }
                        u32x4 w; w.x = cvtpk(v0[0], v0[1]); w.y = cvtpk(v0[2], v0[3]); w.z = cvtpk(v1[0], v1[1]); w.w = cvtpk(v1[2], v1[3]);
                        if (mode == 5) *(u32x4*)(sG + rl * 256 + cl) = w;
                        else if (mode == 6 && u.br < 2) *(u32x4*)(sM + rl * 256 + cl) = w;
                        else if (col0 < ncols) *(u32x4*)(rowp + col0) = w; } } }
    }
};

constexpr int UTAB_OFF = 131072, UTAB_MAX = 64;
__device__ __forceinline__ void utab_build(LAS unsigned char* lds, const StaticOrder& S, int tid) {
    if (tid < UTAB_MAX) { Unit u; u.A = nullptr; u.B = nullptr; u.nt = 0; u.pm = 0; u.pn = 0; u.em = 0; u.br = 0; const bool ok = S.next(tid, u);
        LAS unsigned* e = (LAS unsigned*)(lds + UTAB_OFF + tid * 32); const unsigned long long a = (unsigned long long)(uintptr_t)u.A, b = (unsigned long long)(uintptr_t)u.B;
        e[0] = (unsigned)a; e[1] = (unsigned)(a >> 32); e[2] = (unsigned)b; e[3] = (unsigned)(b >> 32); e[4] = ok ? (unsigned)u.nt : 0u; e[5] = (unsigned)u.pm; e[6] = (unsigned)u.pn; e[7] = (unsigned)(u.em | (u.br << 8)); }
    __syncthreads();
}
struct TabSched {
    LAS unsigned char* lds;
    __device__ __forceinline__ bool next(int i, Unit& u) const {
        if (i >= UTAB_MAX) return false;
        const LAS unsigned* e = (const LAS unsigned*)(lds + UTAB_OFF + i * 32);
        const u32x4 lo = *(const LAS u32x4*)e, hi = *(const LAS u32x4*)(e + 4);
        const unsigned nt = __builtin_amdgcn_readfirstlane(hi.x); if (nt == 0u) return false;
        const unsigned a0 = __builtin_amdgcn_readfirstlane(lo.x), a1 = __builtin_amdgcn_readfirstlane(lo.y), b0 = __builtin_amdgcn_readfirstlane(lo.z), b1 = __builtin_amdgcn_readfirstlane(lo.w);
        u.A = (const char*)(uintptr_t)(((unsigned long long)a1 << 32) | a0); u.B = (const char*)(uintptr_t)(((unsigned long long)b1 << 32) | b0);
        u.nt = (int)nt; u.pm = (int)__builtin_amdgcn_readfirstlane(hi.y); u.pn = (int)__builtin_amdgcn_readfirstlane(hi.z);
        const unsigned eb = __builtin_amdgcn_readfirstlane(hi.w); u.em = (int)(eb & 255u); u.br = (int)(eb >> 8); return true;
    }
};
template <class Epi>
__device__ __forceinline__ void gemm_phase(LAS unsigned char* lds, const Gemm g, const TabSched& S, const Epi& E) {
    int tid_ = threadIdx.x; asm volatile("" : "+v"(tid_));
    const int tid = tid_, wid = __builtin_amdgcn_readfirstlane(tid >> 6), lane = tid & 63, wr = wid >> 2, wc = wid & 3, fr = lane & 15, fq = lane >> 4;
    const int K = g.ld;
    unsigned voffA[2], voffB[2];
#pragma unroll
    for (int i = 0; i < 2; ++i) { int R, C; stage_rc(tid * 16 + i * 8192, R, C); const int Rb = (R & ~31) + perm32(R & 31);
        voffA[i] = (unsigned)(R * K + C) * 2u; voffB[i] = (unsigned)(Rb * K + C) * 2u; }
    const size_t kstep = (size_t)(BK * 2);
    const size_t hstep = (size_t)HALF * K * 2;
    const unsigned ldsw = (unsigned)wid * 1024u;
    const int aoff = lds_byte(wr * 64 + fr, fq * 8), boff = lds_byte(wc * 32 + fr, fq * 8);
#define PG8_SA(b, h) (((b) * 2 + (h)) * HTB)
#define PG8_SB(b, h) ((4 + (b) * 2 + (h)) * HTB)
#define PG8_STAGE(bufoff, gbase, voff) do { _Pragma("unroll") for (int _i = 0; _i < 2; ++_i) \
        __builtin_amdgcn_global_load_lds((const unsigned*)((const char*)(gbase) + (voff)[_i]), (LAS unsigned*)(lds + (bufoff) + ldsw + _i * 8192), 16, 0, 0); } while (0)
#define PG8_LDA(dst, b, h) do { _Pragma("unroll") for (int m = 0; m < 4; ++m) _Pragma("unroll") for (int k = 0; k < 2; ++k) dst[m][k] = *(const LAS bf16x8*)(lds + PG8_SA(b, h) + aoff + m * 2048 + k * 1024); } while (0)
#define PG8_LDB(dst, b, h) do { _Pragma("unroll") for (int n = 0; n < 2; ++n) _Pragma("unroll") for (int k = 0; k < 2; ++k) dst[n][k] = *(const LAS bf16x8*)(lds + PG8_SB(b, h) + boff + n * 2048 + k * 1024); } while (0)
#define PG8_MMA(ai, bj, At, Bt) do { __builtin_amdgcn_s_setprio(1); _Pragma("unroll") for (int m = 0; m < 4; ++m) _Pragma("unroll") for (int n = 0; n < 2; ++n) _Pragma("unroll") for (int k = 0; k < 2; ++k) \
        acc[ai][bj][m][n] = __builtin_amdgcn_mfma_f32_16x16x32_bf16(Bt[n][k], At[m][k], acc[ai][bj][m][n], 0, 0, 0); __builtin_amdgcn_s_setprio(0); } while (0)
#define PG8_WAIT_V(n) asm volatile("s_waitcnt vmcnt(" #n ")" ::: "memory")
#define PG8_WAIT_L(n) asm volatile("s_waitcnt lgkmcnt(" #n ")" ::: "memory")
#define PG8_BAR __builtin_amdgcn_s_barrier()
#define PG8_SCHED __builtin_amdgcn_sched_barrier(0)
    Unit cur, nxt; int ui = 0;
    if (!S.next(0, cur)) return;
    f32x4 acc[2][2][4][2];
#pragma unroll
    for (int a = 0; a < 2; ++a)
#pragma unroll
        for (int b = 0; b < 2; ++b)
#pragma unroll
            for (int m = 0; m < 4; ++m)
#pragma unroll
                for (int n = 0; n < 2; ++n) acc[a][b][m][n] = (f32x4){0.f, 0.f, 0.f, 0.f};
    bf16x8 At[4][2], B0[2][2], B1[2][2];
    const char* cA = cur.A; const char* cB = cur.B;
    PG8_STAGE(PG8_SB(0, 0), cB, voffB); PG8_STAGE(PG8_SB(0, 1), cB + hstep, voffB); PG8_STAGE(PG8_SA(0, 0), cA, voffA); PG8_STAGE(PG8_SA(0, 1), cA + hstep, voffA);
    if (wr == 1) PG8_BAR;
    PG8_WAIT_V(2); PG8_BAR;
    PG8_STAGE(PG8_SB(1, 0), cB + kstep, voffB); PG8_STAGE(PG8_SA(1, 0), cA + kstep, voffA); PG8_STAGE(PG8_SB(1, 1), cB + hstep + kstep, voffB);
    PG8_WAIT_V(6); PG8_BAR;
    for (;;) {
        const bool has_next = S.next(ui + 1, nxt);
        const char* nA = has_next ? nxt.A : cA; const char* nB = has_next ? nxt.B : cB;
        const int nt = cur.nt;
        for (int t = 0; t < nt; t += 2) {
            const bool last = (t == nt - 2);
            const char* a1 = cA + (size_t)(t + 1) * kstep;
            const char* a2 = last ? nA : cA + (size_t)(t + 2) * kstep; const char* b2 = last ? nB : cB + (size_t)(t + 2) * kstep;
            const char* a3 = a2 + kstep; const char* b3 = b2 + kstep;
            PG8_LDB(B0, 0, 0); PG8_LDB(B1, 0, 1); PG8_SCHED; PG8_LDA(At, 0, 0); PG8_STAGE(PG8_SA(1, 1), a1 + hstep, voffA);
            PG8_WAIT_V(8); PG8_WAIT_L(0); PG8_BAR; PG8_MMA(0, 0, At, B0); PG8_MMA(0, 1, At, B1); PG8_BAR; PG8_SCHED;
            PG8_LDA(At, 0, 1); PG8_STAGE(PG8_SB(0, 0), b2, voffB); PG8_STAGE(PG8_SB(0, 1), b2 + hstep, voffB); PG8_STAGE(PG8_SA(0, 0), a2, voffA);
            PG8_WAIT_V(8); PG8_WAIT_L(0); PG8_BAR; PG8_MMA(1, 0, At, B0); PG8_MMA(1, 1, At, B1); PG8_BAR; PG8_SCHED;
            PG8_LDB(B0, 1, 0); PG8_LDB(B1, 1, 1); PG8_SCHED; PG8_LDA(At, 1, 0); PG8_STAGE(PG8_SA(0, 1), a2 + hstep, voffA);
            PG8_WAIT_V(8); PG8_WAIT_L(0); PG8_BAR; PG8_MMA(0, 0, At, B0); PG8_MMA(0, 1, At, B1); PG8_BAR; PG8_SCHED;
            PG8_LDA(At, 1, 1); PG8_STAGE(PG8_SB(1, 0), b3, voffB); PG8_STAGE(PG8_SB(1, 1), b3 + hstep, voffB); PG8_STAGE(PG8_SA(1, 0), a3, voffA);
            PG8_WAIT_V(8); PG8_WAIT_L(0); PG8_BAR; PG8_MMA(1, 0, At, B0); PG8_MMA(1, 1, At, B1); PG8_BAR; PG8_SCHED;
        }
        if (wr == 0) PG8_BAR;
        E(acc, cur, wr, wc, fr, fq);
        if (!has_next) break;
#pragma unroll
        for (int a = 0; a < 2; ++a)
#pragma unroll
            for (int b = 0; b < 2; ++b)
#pragma unroll
                for (int m = 0; m < 4; ++m)
#pragma unroll
                    for (int n = 0; n < 2; ++n) acc[a][b][m][n] = (f32x4){0.f, 0.f, 0.f, 0.f};
        cur = nxt; cA = nA; cB = nB; ++ui;
        if (wr == 1) PG8_BAR;
    }
    PG8_WAIT_V(0);
    PG8_BAR;
#undef PG8_SA
#undef PG8_SB
#undef PG8_STAGE
#undef PG8_LDA
#undef PG8_LDB
#undef PG8_MMA
#undef PG8_WAIT_V
#undef PG8_WAIT_L
#undef PG8_BAR
#undef PG8_SCHED
}
}

struct Args {
    const float* in[17]; float* out; unsigned char* ws; int ph_lo, ph_hi;
};

__device__ __forceinline__ void phase_mods(LAS unsigned char* lds, const float* c, const float* ada_w, const float* ada_b, float* mods) {
    LAS float* sc = (LAS float*)lds;
    int tid_ = threadIdx.x; asm volatile("" : "+v"(tid_)); const int tid = tid_;
    for (int e = tid; e < 32 * 1024; e += 512) { const int b = e >> 10, k = e & 1023; const float v = c[e]; sc[k * 32 + b] = v * sigmoidf_(v); }
    __syncthreads();
    constexpr int NCOLT = DEPTH * 9216;
    for (int it = blockIdx.x; it < NCOLT / 512; it += (gridDim.x > 144 ? 72 : gridDim.x)) {
        const int n = it * 512 + tid, l = n / 9216, col = n % 9216;
        const float* w = ada_w + (size_t)l * 1024 * 9216 + col;
        float acc[32];
#pragma unroll
        for (int b = 0; b < 32; ++b) acc[b] = 0.f;
#pragma unroll 4
        for (int k = 0; k < 1024; ++k) { const float wv = w[(size_t)k * 9216];
#pragma unroll
            for (int q = 0; q < 8; ++q) { const f32x4 cv = *(const LAS f32x4*)(sc + k * 32 + q * 4); acc[q * 4 + 0] += wv * cv.x; acc[q * 4 + 1] += wv * cv.y; acc[q * 4 + 2] += wv * cv.z; acc[q * 4 + 3] += wv * cv.w; } }
        const float bb = ada_b[l * 9216 + col];
#pragma unroll
        for (int b = 0; b < 32; ++b) mods[((size_t)l * 32 + b) * 9216 + col] = acc[b] + bb;
    }
    __syncthreads();
}

__device__ __forceinline__ int wmap(int mode, int n) {
    if (mode == 0) return n;
    if (mode == 1) return ((n >> 2) << 3) + (n & 3);
    if (mode == 2) return ((n >> 2) << 3) + 4 + (n & 3);
    if (n < 2048) return n;
    if (n < 2072) return C_BG + (n - 2048);
    if (n < 3608) return n - 24;
    return NIN + (n - 3608);
}
__device__ __forceinline__ void tr_item(const float* W, int K, int N, bf16_t* WT, int mode, LAS float* scr, int item, int lane, int ldT = 0) {
    if (ldT == 0) ldT = K;
    const int nblk = (N + 31) / 32, kb = item / nblk, nb = item % nblk, k0 = 64 * kb, n0 = 32 * nb;
    const int qn = n0 + 4 * (lane & 7); const bool ok = qn < N;
#pragma unroll
    for (int i = 0; i < 8; ++i) { const int kk = 8 * i + (lane >> 3); const f32x4 v = ok ? *(const f32x4*)(W + (size_t)(k0 + kk) * N + qn) : (f32x4){0.f, 0.f, 0.f, 0.f};
        LAS float* d = scr + kk * 33 + 4 * (lane & 7); d[0] = v.x; d[1] = v.y; d[2] = v.z; d[3] = v.w; }
    asm volatile("s_waitcnt lgkmcnt(0)" ::: "memory");
    const int c = lane & 7;
#pragma unroll
    for (int j = 0; j < 4; ++j) { const int n = (lane >> 3) + 8 * j; const LAS float* s = scr + (8 * c) * 33 + n;
        u32x4 o; o.x = cvtpk(s[0 * 33], s[1 * 33]); o.y = cvtpk(s[2 * 33], s[3 * 33]); o.z = cvtpk(s[4 * 33], s[5 * 33]); o.w = cvtpk(s[6 * 33], s[7 * 33]);
        if (n0 + n < N) *(u32x4*)(WT + (size_t)wmap(mode, n0 + n) * ldT + k0 + 8 * c) = o; }
    asm volatile("s_waitcnt lgkmcnt(0)" ::: "memory");
}
__device__ __forceinline__ void phase_conv(LAS unsigned char* lds, const Args& a, int l, int wg0, int nwg) {
    int tid_ = threadIdx.x; asm volatile("" : "+v"(tid_));
    const int lane = tid_ & 63, wid = __builtin_amdgcn_readfirstlane(tid_ >> 6), gw = ((int)blockIdx.x - wg0) * 8 + wid, NGW = nwg * 8;
    LAS float* scr = (LAS float*)(lds + wid * 8704);
    bf16_t* Wb = (bf16_t*)(a.ws + WS_W);
    const float* wg = a.in[7] + (size_t)l * 2 * DM * FF; const float* wu = a.in[8] + (size_t)l * 2 * DM * FF; const float* wd = a.in[9] + (size_t)l * 2 * FF * DM;
    const float* win = a.in[10] + (size_t)l * DM * INW; const float* w1 = a.in[13] + (size_t)l * 2 * 2048 * 128; const float* w2 = a.in[14] + (size_t)l * 2 * 128 * 64;
    const float* wb = a.in[15] + (size_t)l * 3 * 512 * DM; const float* wo = a.in[16] + (size_t)l * DM * DM;
    constexpr int I_G = (DM / 64) * (FF / 32), I_D = (FF / 64) * (DM / 32), I_IN = (DM / 64) * ((INW + 31) / 32), I_B = (512 / 64) * (DM / 32), I_O = (DM / 64) * (DM / 32),
                  I_1 = (2048 / 64) * (128 / 32), I_2 = (128 / 64) * (64 / 32);
    constexpr int NITEMS = 4 * I_G + 2 * I_D + I_IN + 3 * I_B + I_O + 2 * I_1 + 2 * I_2;
    for (int it = gw; it < NITEMS; it += NGW) {
        int r = it;
        if (r < 4 * I_G) { const int j = r / (2 * I_G), gu = (r / I_G) & 1; tr_item((gu ? wu : wg) + (size_t)j * DM * FF, DM, FF, Wb + W_GU + (size_t)j * 5632 * DM, 1 + gu, scr, r % I_G, lane); continue; } r -= 4 * I_G;
        if (r < 2 * I_D) { const int j = r / I_D; tr_item(wd + (size_t)j * FF * DM, FF, DM, Wb + W_D + (size_t)j * DM * FF, 0, scr, r % I_D, lane); continue; } r -= 2 * I_D;
        if (r < I_IN) { tr_item(win, DM, INW, Wb + W_IN, 3, scr, r, lane); continue; } r -= I_IN;
        if (r < 3 * I_B) { const int j = r / I_B; tr_item(wb + (size_t)j * 512 * DM, 512, DM, (bf16_t*)(a.ws + WS_WB) + (size_t)j * DM * 1024, 0, scr, r % I_B, lane, 1024); continue; } r -= 3 * I_B;
        if (r < I_O) { tr_item(wo, DM, DM, Wb + W_O, 0, scr, r, lane); continue; } r -= I_O;
        if (r < 2 * I_1) { const int j = r / I_1; tr_item(w1 + (size_t)j * 2048 * 128, 2048, 128, Wb + W_1 + (size_t)j * 128 * 2048, 0, scr, r % I_1, lane); continue; } r -= 2 * I_1;
        { const int j = r / I_2; tr_item(w2 + (size_t)j * 128 * 64, 128, 64, Wb + W_2 + (size_t)j * 64 * 128, 0, scr, r % I_2, lane); }
    }
    { const int tot = (NIN - QP) * DM / 8; for (int e = gw * 64 + lane; e < tot; e += NGW * 64) *(u32x4*)(Wb + W_IN + (size_t)QP * DM + (size_t)e * 8) = (u32x4){0u, 0u, 0u, 0u}; }
    { const float* pos = a.in[12] + (size_t)l * 2 * 2048; float* hb = (float*)(a.ws + WS_HB);
      for (int o = gw; o < 256; o += NGW) { const int ty = o >> 7, hid = o & 127; float s = 0.f;
          for (int k = lane; k < 2048; k += 64) s += pos[ty * 2048 + k] * w1[((size_t)ty * 2048 + k) * 128 + hid];
#pragma unroll
          for (int off = 1; off < 64; off <<= 1) s += __shfl_xor(s, off);
          if (lane == 0) hb[o] = s; } }
}

__device__ __forceinline__ void phase_rowwise(const void* xsrc_, bool sbf, void* xdst_, bool dbf, const bf16_t* Y, bf16_t* H, const float* mods, int lprev, int iprev, const float* lnpost, float resw,
                                              int lnext, int inext, const float* lnpre, bool hasprev, bool hasnext) {
    int tid_ = threadIdx.x; asm volatile("" : "+v"(tid_));
    const int lane = tid_ & 63, wid = __builtin_amdgcn_readfirstlane(tid_ >> 6), gw = blockIdx.x * 8 + wid, NGW = gridDim.x * 8;
    const float* xsrc = (const float*)xsrc_; const bf16_t* xsrcb = (const bf16_t*)xsrc_; float* xdst = (float*)xdst_; bf16_t* xdstb = (bf16_t*)xdst_;
    for (int ch = gw; ch < M / 32; ch += NGW) {
        const int b = ch >> 6;
        f32x4 gp[4], na[4], ns[4];
#pragma unroll
        for (int j = 0; j < 4; ++j) { const int c = 4 * lane + 256 * j;
            if (hasprev) { const f32x4 g = *(const f32x4*)(mods + ((size_t)lprev * 32 + b) * 9216 + iprev * 3072 + 2048 + c); const f32x4 lp = *(const f32x4*)(lnpost + c); gp[j] = g * lp * resw; }
            else gp[j] = (f32x4){0.f, 0.f, 0.f, 0.f};
            if (hasnext) { const f32x4 sh = *(const f32x4*)(mods + ((size_t)lnext * 32 + b) * 9216 + inext * 3072 + c); const f32x4 scl = *(const f32x4*)(mods + ((size_t)lnext * 32 + b) * 9216 + inext * 3072 + 1024 + c);
                const f32x4 lp = *(const f32x4*)(lnpre + c); na[j] = lp * (scl + 1.0f); ns[j] = sh; }
            else { na[j] = (f32x4){0.f, 0.f, 0.f, 0.f}; ns[j] = na[j]; } }
        f32x4 xn[2][4]; u32x2 xnb[2][4]; u32x2 yn[2][4];
        { const size_t m0 = (size_t)ch * 32;
#pragma unroll
          for (int r = 0; r < 2; ++r)
#pragma unroll
            for (int j = 0; j < 4; ++j) { if (sbf) { xnb[r][j] = *(const u32x2*)(xsrcb + (m0 + r) * DM + 4 * lane + 256 * j); xn[r][j] = (f32x4){0.f, 0.f, 0.f, 0.f}; } else { xn[r][j] = *(const f32x4*)(xsrc + (m0 + r) * DM + 4 * lane + 256 * j); xnb[r][j] = (u32x2){0u, 0u}; }
                yn[r][j] = hasprev ? *(const u32x2*)(Y + (m0 + r) * DM + 4 * lane + 256 * j) : (u32x2){0u, 0u}; } }
        for (int rr = 0; rr < 32; rr += 2) {
            const size_t m = (size_t)ch * 32 + rr;
            f32x4 x[2][4]; u32x2 yr[2][4];
#pragma unroll
            for (int r = 0; r < 2; ++r)
#pragma unroll
                for (int j = 0; j < 4; ++j) { if (sbf) { const u32x2 u = xnb[r][j]; x[r][j] = (f32x4){bflo(u.x), bfhi(u.x), bflo(u.y), bfhi(u.y)}; } else x[r][j] = xn[r][j]; yr[r][j] = yn[r][j]; }
            if (rr + 2 < 32) {
#pragma unroll
                for (int r = 0; r < 2; ++r)
#pragma unroll
                    for (int j = 0; j < 4; ++j) { if (sbf) xnb[r][j] = *(const u32x2*)(xsrcb + (m + 2 + r) * DM + 4 * lane + 256 * j); else xn[r][j] = *(const f32x4*)(xsrc + (m + 2 + r) * DM + 4 * lane + 256 * j); if (hasprev) yn[r][j] = *(const u32x2*)(Y + (m + 2 + r) * DM + 4 * lane + 256 * j); } }
            if (hasprev) {
                f32x4 y[2][4]; float ss[2] = {0.f, 0.f};
#pragma unroll
                for (int r = 0; r < 2; ++r)
#pragma unroll
                    for (int j = 0; j < 4; ++j) { const u32x2 u = yr[r][j]; y[r][j] = (f32x4){bflo(u.x), bfhi(u.x), bflo(u.y), bfhi(u.y)};
                        ss[r] += (y[r][j].x * y[r][j].x + y[r][j].y * y[r][j].y) + (y[r][j].z * y[r][j].z + y[r][j].w * y[r][j].w); }
#pragma unroll
                for (int off = 1; off < 64; off <<= 1) { ss[0] += __shfl_xor(ss[0], off); ss[1] += __shfl_xor(ss[1], off); }
#pragma unroll
                for (int r = 0; r < 2; ++r) { const float rs = __builtin_amdgcn_rsqf(ss[r] * (1.f / DM) + EPS);
#pragma unroll
                    for (int j = 0; j < 4; ++j) x[r][j] = x[r][j] + gp[j] * (y[r][j] * rs); }
            }
#pragma unroll
            for (int r = 0; r < 2; ++r)
#pragma unroll
                for (int j = 0; j < 4; ++j) { if (hasprev) { if (dbf) { u32x2 w; w.x = cvtpk(x[r][j].x, x[r][j].y); w.y = cvtpk(x[r][j].z, x[r][j].w); *(u32x2*)(xdstb + (m + r) * DM + 4 * lane + 256 * j) = w; } else *(f32x4*)(xdst + (m + r) * DM + 4 * lane + 256 * j) = x[r][j]; } }
            if (hasnext) {
                float ss[2] = {0.f, 0.f};
#pragma unroll
                for (int r = 0; r < 2; ++r)
#pragma unroll
                    for (int j = 0; j < 4; ++j) ss[r] += (x[r][j].x * x[r][j].x + x[r][j].y * x[r][j].y) + (x[r][j].z * x[r][j].z + x[r][j].w * x[r][j].w);
#pragma unroll
                for (int off = 1; off < 64; off <<= 1) { ss[0] += __shfl_xor(ss[0], off); ss[1] += __shfl_xor(ss[1], off); }
#pragma unroll
                for (int r = 0; r < 2; ++r) { const float rs = __builtin_amdgcn_rsqf(ss[r] * (1.f / DM) + EPS);
#pragma unroll
                    for (int j = 0; j < 4; ++j) { const f32x4 h = (x[r][j] * rs) * na[j] + ns[j]; u32x2 w; w.x = cvtpk(h.x, h.y); w.y = cvtpk(h.z, h.w); *(u32x2*)(H + (m + r) * DM + 4 * lane + 256 * j) = w; } }
            }
        }
    }
}

#define LDS_BARRIER() asm volatile("s_waitcnt lgkmcnt(0)\n\ts_barrier" ::: "memory")
#define MFMA16(a, b, c) __builtin_amdgcn_mfma_f32_16x16x32_bf16((a), (b), (c), 0, 0, 0)
constexpr int KPB = 144;
constexpr int ATT_TILE = 9216, ATT_KS = 0, ATT_VS = 2 * ATT_TILE, ATT_LUT = 4 * ATT_TILE, ATT_FLAG = ATT_LUT + 512;
enum { MODE_A = 0, MODE_BWIN = 1, MODE_BSLC = 2, MODE_C = 3 };
typedef short v4i16_t __attribute__((ext_vector_type(4)));
__device__ __forceinline__ v4i16_t tr_read(const LAS unsigned char* p) { return __builtin_amdgcn_ds_read_tr16_b64_v4i16((LAS v4i16_t*)p); }
__device__ __forceinline__ bf16x8 vfrag(const LAS unsigned char* p) { const v4i16_t a = tr_read(p), b = tr_read(p + 16 * KPB); return (bf16x8){a[0], a[1], a[2], a[3], b[0], b[1], b[2], b[3]}; }

__device__ __forceinline__ void store_row16(bf16_t* rowp, int g, const u32x2 (&pk)[4]) {
    const int par = g & 1;
#pragma unroll
    for (int pr = 0; pr < 2; ++pr) {
        const auto sx = __builtin_amdgcn_permlane16_swap(pk[2 * pr].x, pk[2 * pr + 1].x, false, false);
        const auto sy = __builtin_amdgcn_permlane16_swap(pk[2 * pr].y, pk[2 * pr + 1].y, false, false);
        u32x4 w; w.x = sx[0]; w.y = sy[0]; w.z = sx[1]; w.w = sy[1];
        *(u32x4*)(rowp + 16 * (2 * pr + par) + 4 * (g - par)) = w; }
}

template <int MODE>
__device__ __forceinline__ void attn_pass(LAS unsigned char* lds, const bf16_t* base, int gk, int q0, const float* relb_b, const unsigned* selrow, f32x4 (&o)[2][4]) {
    int tid_ = threadIdx.x; asm volatile("" : "+v"(tid_));
    const int tid = tid_, lane = tid & 63, wid = __builtin_amdgcn_readfirstlane(tid >> 6), c = lane & 15, g = lane >> 4;
    constexpr int W = (MODE == MODE_BWIN) ? 512 : 1 << 20;
    constexpr float LOG2E = 1.4426950408889634f, C1 = 0.125f * LOG2E;
    const int hh = wid & 3, h = gk * 4 + hh;
    const bf16_t* qp = base + C_BQ + h * 64;
    const bf16_t* kp = base + (MODE == MODE_BSLC ? C_BKS : C_BKW) + gk * 64;
    const bf16_t* vp = base + (MODE == MODE_BSLC ? C_BVS : C_BVW) + gk * 64;
    LAS float* lutw = (LAS float*)(lds + ATT_LUT);
    const LAS float* lut = lutw + hh * 128;
    const int qw0 = q0 + (wid >> 2) * 32;
    bf16x8 qf[2][2];
#pragma unroll
    for (int qt = 0; qt < 2; ++qt)
#pragma unroll
        for (int ks = 0; ks < 2; ++ks) qf[qt][ks] = *(const bf16x8*)(qp + (size_t)(qw0 + qt * 16 + c) * QP + ks * 32 + g * 8);
    const int kb_hi = q0 >> 6;
    unsigned todo;
    unsigned sel[2] = {0xffffffffu, 0xffffffffu};
    unsigned selw = 0xffffffffu;
    if (MODE == MODE_BSLC) {
        sel[0] = selrow[qw0 + c]; sel[1] = selrow[qw0 + 16 + c];
        unsigned u = sel[0] | sel[1];
#pragma unroll
        for (int off = 1; off < 64; off <<= 1) u |= __shfl_xor(u, off);
        selw = __builtin_amdgcn_readfirstlane(u);
        unsigned v = selrow[q0 + lane];
#pragma unroll
        for (int off = 1; off < 64; off <<= 1) v |= __shfl_xor(v, off);
        todo = __builtin_amdgcn_readfirstlane(v) & (0xffffffffu >> (31 - kb_hi));
    } else {
        const int kb_lo = kb_hi >= 8 ? kb_hi - 8 : 0;
        todo = (0xffffffffu >> (31 - kb_hi)) & (0xffffffffu << kb_lo);
    }
    __syncthreads();
    if (tid < 512) { const int e = tid; lutw[e] = relb_b[(int)T5B[e & 127] * 16 + gk * 4 + (e >> 7)] * LOG2E; }
    const float bias_far = relb_b[31 * 16 + h] * LOG2E;
#pragma unroll
    for (int qt = 0; qt < 2; ++qt)
#pragma unroll
        for (int dt = 0; dt < 4; ++dt) o[qt][dt] = (f32x4){0.f, 0.f, 0.f, 0.f};
    float mrun[2] = {-1e30f, -1e30f}, lrun[2] = {0.f, 0.f};
    const int skey = tid >> 3, sch = tid & 7;
    const unsigned soff = skey * KPB + sch * 16;
    u32x4 kreg, vreg;
    int kb = 31 - __builtin_clz(todo); todo &= ~(1u << kb);
    { const size_t ro = (size_t)(kb * 64 + skey) * QP + sch * 8; kreg = *(const u32x4*)(kp + ro); vreg = *(const u32x4*)(vp + ro); }
    *(LAS u32x4*)(lds + ATT_KS + soff) = kreg; *(LAS u32x4*)(lds + ATT_VS + soff) = vreg;
    int kbn = todo ? 31 - __builtin_clz(todo) : -1; if (kbn >= 0) todo &= ~(1u << kbn);
    if (kbn >= 0) { const size_t ro = (size_t)(kbn * 64 + skey) * QP + sch * 8; kreg = *(const u32x4*)(kp + ro); vreg = *(const u32x4*)(vp + ro); }
    LDS_BARRIER();
    int buf = 0;
    while (kb >= 0) {
        const int kbnn = todo ? 31 - __builtin_clz(todo) : -1; if (kbnn >= 0) todo &= ~(1u << kbnn);
        if (kbn >= 0) { *(LAS u32x4*)(lds + ATT_KS + (buf ^ 1) * ATT_TILE + soff) = kreg; *(LAS u32x4*)(lds + ATT_VS + (buf ^ 1) * ATT_TILE + soff) = vreg; }
        if (kbnn >= 0) { const size_t ro = (size_t)(kbnn * 64 + skey) * QP + sch * 8; kreg = *(const u32x4*)(kp + ro); vreg = *(const u32x4*)(vp + ro); }
        const LAS unsigned char* Ks = lds + ATT_KS + buf * ATT_TILE; const LAS unsigned char* Vs = lds + ATT_VS + buf * ATT_TILE;
        const int k0 = kb * 64;
        const bool need = (MODE == MODE_BSLC) ? (((selw >> kb) & 1u) != 0u) : true;
        if (need) {
        bf16x8 kfr[4][2], vfr[4][2];
#pragma unroll
        for (int nt = 0; nt < 4; ++nt) { kfr[nt][0] = *(const LAS bf16x8*)(Ks + (16 * nt + c) * KPB + g * 16); kfr[nt][1] = *(const LAS bf16x8*)(Ks + (16 * nt + c) * KPB + 64 + g * 16); }
        { const LAS unsigned char* vb = Vs + (4 * g + (c >> 2)) * KPB + (c & 3) * 8;
#pragma unroll
          for (int dt = 0; dt < 4; ++dt)
#pragma unroll
            for (int p = 0; p < 2; ++p) vfr[dt][p] = vfrag(vb + 32 * p * KPB + dt * 32); }
        __builtin_amdgcn_sched_barrier(0);
        f32x4 s[2][4];
#pragma unroll
        for (int nt = 0; nt < 4; ++nt) {
#pragma unroll
            for (int qt = 0; qt < 2; ++qt) { f32x4 z = (f32x4){0.f, 0.f, 0.f, 0.f}; z = MFMA16(kfr[nt][0], qf[qt][0], z); s[qt][nt] = MFMA16(kfr[nt][1], qf[qt][1], z); }
        }
        const bool far = (qw0 - (k0 + 63)) >= 113;
        const bool fast = far && ((qw0 + 31 - k0) < W);
#pragma unroll
        for (int qt = 0; qt < 2; ++qt) {
            const bool selb = (MODE == MODE_BSLC) ? (((sel[qt] >> kb) & 1u) != 0u) : true;
            float mnew, alpha;
            if (fast) {
                float mx = fmaxf(fmaxf(s[qt][0][0], s[qt][0][1]), fmaxf(s[qt][0][2], s[qt][0][3]));
#pragma unroll
                for (int nt = 1; nt < 4; ++nt) mx = fmaxf(mx, fmaxf(fmaxf(s[qt][nt][0], s[qt][nt][1]), fmaxf(s[qt][nt][2], s[qt][nt][3])));
                mx = fmaxf(mx, __shfl_xor(mx, 16)); mx = fmaxf(mx, __shfl_xor(mx, 32));
                const float mxl = selb ? (mx * C1 + bias_far) : -1e30f;
                mnew = fmaxf(mrun[qt], mxl); alpha = __builtin_amdgcn_exp2f(mrun[qt] - mnew);
                const float c1 = selb ? C1 : 0.f, c2 = selb ? (bias_far - mnew) : -1e30f;
#pragma unroll
                for (int nt = 0; nt < 4; ++nt)
#pragma unroll
                    for (int j = 0; j < 4; ++j) s[qt][nt][j] = __builtin_amdgcn_exp2f(s[qt][nt][j] * c1 + c2);
            } else {
                const int dbase = selb ? (qw0 + 16 * qt + c - k0 - 4 * g) : -(1 << 22);
                float mx = -1e30f;
#pragma unroll
                for (int nt = 0; nt < 4; ++nt)
#pragma unroll
                    for (int j = 0; j < 4; ++j) { const int dist = dbase - (16 * nt + j); const bool valid = (unsigned)dist < (unsigned)W;
                        const unsigned di = (unsigned)dist < 127u ? (unsigned)dist : 127u;
                        const float lg = valid ? (s[qt][nt][j] * C1 + lut[di]) : -1e30f; s[qt][nt][j] = lg; mx = fmaxf(mx, lg); }
                mx = fmaxf(mx, __shfl_xor(mx, 16)); mx = fmaxf(mx, __shfl_xor(mx, 32));
                mnew = fmaxf(mrun[qt], mx); alpha = __builtin_amdgcn_exp2f(mrun[qt] - mnew);
#pragma unroll
                for (int nt = 0; nt < 4; ++nt)
#pragma unroll
                    for (int j = 0; j < 4; ++j) s[qt][nt][j] = __builtin_amdgcn_exp2f(s[qt][nt][j] - mnew);
            }
            float ps = 0.f;
#pragma unroll
            for (int nt = 0; nt < 4; ++nt) ps += (s[qt][nt][0] + s[qt][nt][1]) + (s[qt][nt][2] + s[qt][nt][3]);
            lrun[qt] = lrun[qt] * alpha + ps;
            if (__any(mnew > mrun[qt])) {
#pragma unroll
                for (int dt = 0; dt < 4; ++dt) o[qt][dt] = o[qt][dt] * alpha; }
            mrun[qt] = mnew;
        }
        bf16x8 pb[2][2];
#pragma unroll
        for (int qt = 0; qt < 2; ++qt)
#pragma unroll
            for (int p = 0; p < 2; ++p) { u32x4 w; w.x = cvtpk(s[qt][2 * p][0], s[qt][2 * p][1]); w.y = cvtpk(s[qt][2 * p][2], s[qt][2 * p][3]);
                w.z = cvtpk(s[qt][2 * p + 1][0], s[qt][2 * p + 1][1]); w.w = cvtpk(s[qt][2 * p + 1][2], s[qt][2 * p + 1][3]); pb[qt][p] = __builtin_bit_cast(bf16x8, w); }
#pragma unroll
        for (int dt = 0; dt < 4; ++dt)
#pragma unroll
            for (int p = 0; p < 2; ++p) {
#pragma unroll
                for (int qt = 0; qt < 2; ++qt) o[qt][dt] = MFMA16(vfr[dt][p], pb[qt][p], o[qt][dt]); }
        }
        LDS_BARRIER();
        kb = kbn; kbn = kbnn; buf ^= 1;
    }
#pragma unroll
    for (int qt = 0; qt < 2; ++qt) { float l = lrun[qt]; l += __shfl_xor(l, 16); l += __shfl_xor(l, 32);
        const float inv = 1.f / l;
#pragma unroll
        for (int dt = 0; dt < 4; ++dt) o[qt][dt] = o[qt][dt] * inv; }
}

constexpr int AW_VT = 0, AW_LUT = 8 * ATT_TILE;
template <int MODE>
__device__ __forceinline__ void attn_wave(LAS unsigned char* lds, const bf16_t* qkv, bf16_t* Yout, const float* sinks, int wi) {
    int tid_ = threadIdx.x; asm volatile("" : "+v"(tid_));
    const int lane = tid_ & 63, wid = __builtin_amdgcn_readfirstlane(tid_ >> 6), c = lane & 15, g = lane >> 4;
    constexpr float LOG2E = 1.4426950408889634f, C1 = 0.125f * LOG2E;
    constexpr int NQT = 4;
    const int qb = (MODE == MODE_A) ? (wi & 127) : (wi & 31), h = (MODE == MODE_A) ? ((wi >> 7) & 1) * 4 : ((wi >> 5) & 7), b = wi >> 8;
    const int q0 = (MODE == MODE_A) ? qb * 16 : qb * 64;
    constexpr int QSTEP = (MODE == MODE_A) ? 0 : 16, HSTEP = (MODE == MODE_A) ? 1 : 0;
    const bf16_t* base = qkv + (size_t)b * SEQ * QP;
    const bf16_t* qp = base + (MODE == MODE_A ? C_AQ + h * 64 : C_CQ + h * 64);
    const bf16_t* kp = base + (MODE == MODE_A ? C_AK + (h >> 2) * 64 : C_CK + h * 64);
    const bf16_t* vp = base + (MODE == MODE_A ? C_AV + (h >> 2) * 64 : C_CV + h * 64);
    LAS unsigned char* Vs = lds + AW_VT + wid * ATT_TILE;
    const LAS float* lutp = (const LAS float*)(lds + AW_LUT) + h * 128;
    bf16x8 qf[NQT][2];
#pragma unroll
    for (int qt = 0; qt < NQT; ++qt)
#pragma unroll
        for (int ks = 0; ks < 2; ++ks) qf[qt][ks] = *(const bf16x8*)(qp + (size_t)(q0 + qt * QSTEP + c) * QP + qt * HSTEP * 64 + ks * 32 + g * 8);
    f32x4 o[NQT][4];
#pragma unroll
    for (int qt = 0; qt < NQT; ++qt)
#pragma unroll
        for (int dt = 0; dt < 4; ++dt) o[qt][dt] = (f32x4){0.f, 0.f, 0.f, 0.f};
    float mrun[NQT], lrun[NQT], carry[NQT];
#pragma unroll
    for (int qt = 0; qt < NQT; ++qt) { mrun[qt] = -1e30f; lrun[qt] = 0.f; carry[qt] = 0.f; }
    const int kb_hi = (MODE == MODE_A) ? ((q0 + 15) >> 5) : ((q0 + 63) >> 5);
    int kb_lo = 0;
    if (MODE == MODE_A) { const int lo = q0 - 127; kb_lo = lo > 0 ? (lo >> 5) : 0; }
    for (int kb = kb_hi; kb >= kb_lo; --kb) {
        const int k0 = kb * 32;
        u32x4 vr[4];
#pragma unroll
        for (int i = 0; i < 4; ++i) { const int e = lane + 64 * i; vr[i] = *(const u32x4*)(vp + (size_t)(k0 + (e >> 3)) * QP + (e & 7) * 8); }
        bf16x8 kf[2][2];
#pragma unroll
        for (int nt = 0; nt < 2; ++nt)
#pragma unroll
            for (int ks = 0; ks < 2; ++ks) kf[nt][ks] = *(const bf16x8*)(kp + (size_t)(k0 + 16 * nt + c) * QP + ks * 32 + g * 8);
#pragma unroll
        for (int i = 0; i < 4; ++i) { const int e = lane + 64 * i; *(LAS u32x4*)(Vs + (e >> 3) * KPB + (e & 7) * 16) = vr[i]; }
        bf16x8 vfr[4];
        { const LAS unsigned char* vb = Vs + (4 * g + (c >> 2)) * KPB + (c & 3) * 8;
#pragma unroll
          for (int dt = 0; dt < 4; ++dt) vfr[dt] = vfrag(vb + dt * 32); }
        __builtin_amdgcn_sched_barrier(0);
#pragma unroll
        for (int qt = 0; qt < NQT; ++qt) {
            bool live = (k0 <= q0 + QSTEP * qt + 15);
            if (MODE == MODE_A) live = live && (q0 + QSTEP * qt - (k0 + 31) < 128);
            if (MODE == MODE_C) { const bool dq = __all(carry[qt] < -150.1f); live = live && !dq; }
            if (!live) continue;
            f32x4 s[2];
#pragma unroll
            for (int nt = 0; nt < 2; ++nt) { f32x4 z = (f32x4){0.f, 0.f, 0.f, 0.f}; z = MFMA16(kf[nt][0], qf[qt][0], z); s[nt] = MFMA16(kf[nt][1], qf[qt][1], z); }
            const int dbase = q0 + QSTEP * qt + c - k0 - 4 * g;
            if (MODE == MODE_A) {
                float mx = -1e30f;
#pragma unroll
                for (int nt = 0; nt < 2; ++nt)
#pragma unroll
                    for (int j = 0; j < 4; ++j) { const int dist = dbase - (16 * nt + j); const bool valid = (unsigned)dist < 128u;
                        const float bias2 = lutp[qt * HSTEP * 128 + (dist & 127)];
                        const float lg = valid ? (s[nt][j] * C1 + bias2) : -1e30f; s[nt][j] = lg; mx = fmaxf(mx, lg); }
                mx = fmaxf(mx, __shfl_xor(mx, 16)); mx = fmaxf(mx, __shfl_xor(mx, 32));
                const float mnew = fmaxf(mrun[qt], mx); const float alpha = __builtin_amdgcn_exp2f(mrun[qt] - mnew); mrun[qt] = mnew;
                float ps = 0.f;
#pragma unroll
                for (int nt = 0; nt < 2; ++nt)
#pragma unroll
                    for (int j = 0; j < 4; ++j) { const float p = __builtin_amdgcn_exp2f(s[nt][j] - mnew); s[nt][j] = p; ps += p; }
                lrun[qt] = lrun[qt] * alpha + ps;
#pragma unroll
                for (int dt = 0; dt < 4; ++dt) o[qt][dt] = o[qt][dt] * alpha;
            } else {
                float lk[2][4], c4[2];
#pragma unroll
                for (int nt = 0; nt < 2; ++nt) { c4[nt] = 0.f;
#pragma unroll
                    for (int j = 0; j < 4; ++j) { const bool valid = (dbase - (16 * nt + j)) > 0; const float z = s[nt][j] * C1;
                        const float e = __builtin_amdgcn_exp2f(-fabsf(z));
                        const float sp = fmaxf(z, 0.f) + __builtin_amdgcn_logf(1.f + e);
                        lk[nt][j] = valid ? -sp : 0.f; s[nt][j] = valid ? (z - sp) : -1e30f; c4[nt] += lk[nt][j]; } }
                float after = 0.f;
#pragma unroll
                for (int nt = 1; nt >= 0; --nt) {
                    const float v1 = __shfl_xor(c4[nt], 16), v2 = __shfl_xor(c4[nt], 32), v3 = __shfl_xor(c4[nt], 48);
                    const float G = (((g ^ 1) > g) ? v1 : 0.f) + (((g ^ 2) > g) ? v2 : 0.f) + (((g ^ 3) > g) ? v3 : 0.f);
                    const float T = c4[nt] + v1 + v2 + v3;
                    float sfx = carry[qt] + after + G;
#pragma unroll
                    for (int j = 3; j >= 0; --j) { const float w = __builtin_amdgcn_exp2f(s[nt][j] + sfx); s[nt][j] = w; sfx += lk[nt][j]; }
                    after += T;
                }
                carry[qt] += after;
            }
            u32x4 w; w.x = cvtpk(s[0][0], s[0][1]); w.y = cvtpk(s[0][2], s[0][3]); w.z = cvtpk(s[1][0], s[1][1]); w.w = cvtpk(s[1][2], s[1][3]);
            const bf16x8 pb = __builtin_bit_cast(bf16x8, w);
#pragma unroll
            for (int dt = 0; dt < 4; ++dt) o[qt][dt] = MFMA16(vfr[dt], pb, o[qt][dt]);
        }
        if (MODE == MODE_C) {
            bool dn = (k0 <= q0);
#pragma unroll
            for (int qt = 0; qt < NQT; ++qt) dn = dn && (carry[qt] < -150.1f);
            if (__all(dn)) break;
        }
    }
    if (MODE == MODE_A) {
#pragma unroll
        for (int qt = 0; qt < NQT; ++qt) { float l = lrun[qt]; l += __shfl_xor(l, 16); l += __shfl_xor(l, 32);
            const float sk2 = sinks[h + qt * HSTEP] * LOG2E;
            l += __builtin_amdgcn_exp2f(sk2 - mrun[qt]);
            const float inv = 1.f / l;
#pragma unroll
            for (int dt = 0; dt < 4; ++dt) o[qt][dt] = o[qt][dt] * inv; }
    }
#pragma unroll
    for (int qt = 0; qt < NQT; ++qt) { const size_t row = (size_t)b * SEQ + q0 + qt * QSTEP + c;
        u32x2 pk[4];
#pragma unroll
        for (int dt = 0; dt < 4; ++dt) { pk[dt].x = cvtpk(o[qt][dt][0], o[qt][dt][1]); pk[dt].y = cvtpk(o[qt][dt][2], o[qt][dt][3]); }
        store_row16(Yout + row * YP + (h + qt * HSTEP) * 64, g, pk); }
}

__device__ __forceinline__ void item_attn_b(LAS unsigned char* lds, const bf16_t* qkv, bf16_t* Yb, const bf16_t* Ycmp, const float* relb, const unsigned* selm, int it) {
    const int t64 = 31 - (it >> 6), gk = it & 1, b = (it >> 1) & 31; const int q0 = t64 * 64; const bf16_t* base = qkv + (size_t)b * SEQ * QP;
    int tid_ = threadIdx.x; asm volatile("" : "+v"(tid_));
    const int lane = tid_ & 63, wid = tid_ >> 6, c = lane & 15, g = lane >> 4;
    const int h = gk * 4 + (wid & 3), qw0 = q0 + (wid >> 2) * 32;
    f32x4 o1[2][4], o2[2][4];
    attn_pass<MODE_BSLC>(lds, base, gk, q0, relb + 8, selm + ((size_t)b * 2 + gk) * SEQ, o1);
    attn_pass<MODE_BWIN>(lds, base, gk, q0, relb + 8, nullptr, o2);
#pragma unroll
    for (int qt = 0; qt < 2; ++qt) { const size_t row = (size_t)b * SEQ + qw0 + qt * 16 + c;
        const float g1 = sigmoidf_(bf2f(qkv[row * QP + C_BG + 8 + h])), g2 = sigmoidf_(bf2f(qkv[row * QP + C_BG + 16 + h]));
        const int par = g & 1;
#pragma unroll
        for (int pr = 0; pr < 2; ++pr) {
            const f32x4 ra = o1[qt][2 * pr] * g1 + o2[qt][2 * pr] * g2, rb = o1[qt][2 * pr + 1] * g1 + o2[qt][2 * pr + 1] * g2;
            float lo[4], hi[4];
#pragma unroll
            for (int e = 0; e < 4; ++e) { const auto sw = __builtin_amdgcn_permlane16_swap(__float_as_uint(ra[e]), __float_as_uint(rb[e]), false, false); lo[e] = __uint_as_float(sw[0]); hi[e] = __uint_as_float(sw[1]); }
            const int dofs = h * 64 + 16 * (2 * pr + par) + 4 * (g - par);
            const u32x4 old = *(const u32x4*)(Ycmp + row * 512 + dofs);
            u32x4 w; w.x = cvtpk(lo[0] + bflo(old.x), lo[1] + bfhi(old.x)); w.y = cvtpk(lo[2] + bflo(old.y), lo[3] + bfhi(old.y));
            w.z = cvtpk(hi[0] + bflo(old.z), hi[1] + bfhi(old.z)); w.w = cvtpk(hi[2] + bflo(old.w), hi[3] + bfhi(old.w));
            *(u32x4*)(Yb + row * YP + dofs) = w; } }
}

__device__ __forceinline__ void item_cmpk(const bf16_t* qkv, const bf16_t* Wb, const float* hb, bf16_t* KC, int it, int wsub) {
    int tid_ = threadIdx.x; asm volatile("" : "+v"(tid_));
    const int lane = tid_ & 63, wid = wsub, c = lane & 15, g = lane >> 4;
    const int ty = it & 1, gk = (it >> 1) & 1, b = it >> 2;
    const int n = 16 * wid + c, nn = n < 127 ? n : 126;
    const bf16_t* src = qkv + ((size_t)b * SEQ + 16 * nn) * QP + (ty ? C_BVC : C_BKC) + gk * 64 + g * 8;
    const bf16_t* w1t = Wb + W_1 + (size_t)ty * 128 * 2048 + (size_t)c * 2048 + g * 8;
    f32x4 hT[8];
#pragma unroll
    for (int ht = 0; ht < 8; ++ht) hT[ht] = (f32x4){0.f, 0.f, 0.f, 0.f};
#pragma unroll 2
    for (int ks = 0; ks < 64; ++ks) {
        const bf16x8 bfrag = *(const bf16x8*)(src + (size_t)(ks >> 1) * QP + (ks & 1) * 32);
#pragma unroll
        for (int ht = 0; ht < 8; ++ht) { const bf16x8 afrag = *(const bf16x8*)(w1t + (size_t)ht * 16 * 2048 + ks * 32); hT[ht] = MFMA16(afrag, bfrag, hT[ht]); }
    }
#pragma unroll
    for (int ht = 0; ht < 8; ++ht)
#pragma unroll
        for (int j = 0; j < 4; ++j) { const float x = hT[ht][j] + hb[ty * 128 + 16 * ht + 4 * g + j]; const float u = 0.7978845608028654f * (x + 0.044715f * x * x * x);
            const float th = 1.f - 2.f * fast_rcp(1.f + __expf(2.f * u)); hT[ht][j] = 0.5f * x * (1.f + th); }
    f32x4 oT[4];
#pragma unroll
    for (int dt = 0; dt < 4; ++dt) oT[dt] = (f32x4){0.f, 0.f, 0.f, 0.f};
    const bf16_t* w2t = Wb + W_2 + (size_t)ty * 64 * 128;
#pragma unroll
    for (int p = 0; p < 4; ++p) { u32x4 w; w.x = cvtpk(hT[2 * p][0], hT[2 * p][1]); w.y = cvtpk(hT[2 * p][2], hT[2 * p][3]); w.z = cvtpk(hT[2 * p + 1][0], hT[2 * p + 1][1]); w.w = cvtpk(hT[2 * p + 1][2], hT[2 * p + 1][3]);
        const bf16x8 bfrag = __builtin_bit_cast(bf16x8, w);
#pragma unroll
        for (int dt = 0; dt < 4; ++dt) { const bf16_t* ap = w2t + (size_t)(16 * dt + c) * 128 + 32 * p + 4 * g; const u32x2 a0 = *(const u32x2*)ap, a1 = *(const u32x2*)(ap + 16);
            u32x4 aw; aw.x = a0.x; aw.y = a0.y; aw.z = a1.x; aw.w = a1.y; oT[dt] = MFMA16(__builtin_bit_cast(bf16x8, aw), bfrag, oT[dt]); } }
    if (n < 127) { bf16_t* dst = KC + ((((size_t)ty * 32 + b) * 2 + gk) * 128 + n) * 64;
#pragma unroll
        for (int dt = 0; dt < 4; ++dt) { u32x2 w; w.x = cvtpk(oT[dt][0], oT[dt][1]); w.y = cvtpk(oT[dt][2], oT[dt][3]); *(u32x2*)(dst + 16 * dt + 4 * g) = w; } }
}

constexpr int CMP_KS = 0, CMP_KPB = 144, CMP_VT = 128 * 144, CMP_VPB = 272, CMP_IMP = 36864;
__device__ __forceinline__ void item_attn_cmp(LAS unsigned char* lds, const bf16_t* qkv, const bf16_t* KC, bf16_t* Yb, unsigned* selm, int it) {
    int tid_ = threadIdx.x; asm volatile("" : "+v"(tid_));
    const int tid = tid_, lane = tid & 63, wid = tid >> 6, c = lane & 15, g = lane >> 4;
    const int q16 = it & 15, gk = (it >> 4) & 1, b = it >> 5; const int q0 = q16 * 128;
    LAS unsigned char* Ks = lds + CMP_KS; LAS unsigned char* Vt = lds + CMP_VT;
    const bf16_t* kc = KC + (((size_t)0 * 32 + b) * 2 + gk) * 128 * 64; const bf16_t* vc = KC + (((size_t)1 * 32 + b) * 2 + gk) * 128 * 64;
    __syncthreads();
#pragma unroll
    for (int r = 0; r < 2; ++r) { const int e = tid + 512 * r; const int key = e >> 3, ch = e & 7;
        u32x4 kv = (u32x4){0u, 0u, 0u, 0u}, vv = kv;
        if (key < 127) { kv = *(const u32x4*)(kc + key * 64 + ch * 8); vv = *(const u32x4*)(vc + key * 64 + ch * 8); }
        *(LAS u32x4*)(Ks + key * CMP_KPB + ch * 16) = kv; *(LAS u32x4*)(Vt + key * CMP_KPB + ch * 16) = vv; }
    __syncthreads();
    const int t = q0 + wid * 16 + c; const size_t row = (size_t)b * SEQ + t;
    float psum[8][4];
#pragma unroll
    for (int nt = 0; nt < 8; ++nt)
#pragma unroll
        for (int j = 0; j < 4; ++j) psum[nt][j] = 0.f;
#pragma unroll 1
    for (int hh = 0; hh < 4; ++hh) {
        const int h = gk * 4 + hh;
        const bf16x8 qf0 = *(const bf16x8*)(qkv + row * QP + C_BQ + h * 64 + g * 8), qf1 = *(const bf16x8*)(qkv + row * QP + C_BQ + h * 64 + 32 + g * 8);
        f32x4 s[8]; float mx = -1e30f;
#pragma unroll
        for (int nt = 0; nt < 8; ++nt) { const bf16x8 kf0 = *(const LAS bf16x8*)(Ks + (16 * nt + c) * CMP_KPB + g * 16), kf1 = *(const LAS bf16x8*)(Ks + (16 * nt + c) * CMP_KPB + 64 + g * 16);
            f32x4 z = (f32x4){0.f, 0.f, 0.f, 0.f}; z = MFMA16(kf0, qf0, z); z = MFMA16(kf1, qf1, z);
#pragma unroll
            for (int j = 0; j < 4; ++j) { const int n = 16 * nt + 4 * g + j; const bool valid = (16 * n + 31) <= t; const float lg = valid ? z[j] * 0.125f : -1e30f; z[j] = lg; mx = fmaxf(mx, lg); }
            s[nt] = z; }
        mx = fmaxf(mx, __shfl_xor(mx, 16)); mx = fmaxf(mx, __shfl_xor(mx, 32));
        float sum = 0.f;
#pragma unroll
        for (int nt = 0; nt < 8; ++nt)
#pragma unroll
            for (int j = 0; j < 4; ++j) { const float lg = s[nt][j]; const float e = (lg > -1e29f) ? __expf(lg - mx) : 0.f; s[nt][j] = e; sum += e; }
        sum += __shfl_xor(sum, 16); sum += __shfl_xor(sum, 32);
        const float inv = sum > 0.f ? 1.f / sum : 0.f;
#pragma unroll
        for (int nt = 0; nt < 8; ++nt)
#pragma unroll
            for (int j = 0; j < 4; ++j) { const float p = s[nt][j] * inv; s[nt][j] = p; psum[nt][j] += p; }
        f32x4 o[4];
#pragma unroll
        for (int dt = 0; dt < 4; ++dt) o[dt] = (f32x4){0.f, 0.f, 0.f, 0.f};
#pragma unroll
        for (int p = 0; p < 4; ++p) { u32x4 w; w.x = cvtpk(s[2 * p][0], s[2 * p][1]); w.y = cvtpk(s[2 * p][2], s[2 * p][3]); w.z = cvtpk(s[2 * p + 1][0], s[2 * p + 1][1]); w.w = cvtpk(s[2 * p + 1][2], s[2 * p + 1][3]);
            const bf16x8 pbf = __builtin_bit_cast(bf16x8, w);
#pragma unroll
            for (int dt = 0; dt < 4; ++dt) { const bf16x8 vf = vfrag(Vt + (32 * p + 4 * g + (c >> 2)) * CMP_KPB + dt * 32 + (c & 3) * 8); o[dt] = MFMA16(vf, pbf, o[dt]); } }
        const float g0 = sigmoidf_(bf2f(qkv[row * QP + C_BG + h]));
        { u32x2 pk[4];
#pragma unroll
          for (int dt = 0; dt < 4; ++dt) { pk[dt].x = cvtpk(o[dt][0] * g0, o[dt][1] * g0); pk[dt].y = cvtpk(o[dt][2] * g0, o[dt][3] * g0); }
          store_row16(Yb + row * 512 + h * 64, g, pk); }
    }
    float imp[8], sh3[8];
#pragma unroll
    for (int nt = 0; nt < 8; ++nt) sh3[nt] = __shfl(psum[nt][3], (lane + 48) & 63);
#pragma unroll
    for (int nt = 0; nt < 8; ++nt) { const float prev = (g > 0) ? sh3[nt] : (nt > 0 ? sh3[nt > 0 ? nt - 1 : 0] : 0.f); imp[nt] = (psum[nt][0] + psum[nt][1]) + (psum[nt][2] + psum[nt][3]) + prev; }
    const int cur = t >> 6; const int nforced = cur >= 2 ? 3 : cur + 1; const int nfree = 16 - nforced;
    LAS float* impl = (LAS float*)(lds + CMP_IMP) + (wid * 16 + c) * 33;
#pragma unroll
    for (int nt = 0; nt < 8; ++nt) impl[4 * nt + g] = imp[nt];
    asm volatile("s_waitcnt lgkmcnt(0)" ::: "memory");
    int rank[8];
#pragma unroll
    for (int nt = 0; nt < 8; ++nt) rank[nt] = 0;
#pragma unroll 1
    for (int jb2 = 1; jb2 <= cur - 2; ++jb2) {
        const float v = impl[jb2];
#pragma unroll
        for (int nt = 0; nt < 8; ++nt) { const int jb = 4 * nt + g; rank[nt] += ((v > imp[nt]) || (v == imp[nt] && jb2 < jb)) ? 1 : 0; }
    }
    unsigned bits = 0u;
#pragma unroll
    for (int nt = 0; nt < 8; ++nt) { const int jb = 4 * nt + g; const bool forced = (jb == 0) || (jb == cur) || (jb == cur - 1); const bool cand = (jb >= 1) && (jb <= cur - 2);
        if (forced || (cand && rank[nt] < nfree)) bits |= (1u << jb); }
    bits |= __shfl_xor(bits, 16); bits |= __shfl_xor(bits, 32);
    if (g == 0) selm[((size_t)b * 2 + gk) * SEQ + t] = bits;
}


#define XB_TMO      128
#define XB_XCNT(j)  (256  + 64 * (j))
#define XB_XSUB(j)  (1280 + 64 * (j))
#define XB_XGEN(j)  (2304 + 64 * (j))
#define XB_TOP      3328
#define XB_TOPGEN   3392
#define XCD_BAR_WORDS 3456
#define XB_SPIN_CAP (1u << 22)
__device__ __forceinline__ unsigned xb_ld(unsigned* p)              { return __hip_atomic_load(p, __ATOMIC_RELAXED, __HIP_MEMORY_SCOPE_AGENT); }
__device__ __forceinline__ unsigned xb_add(unsigned* p, unsigned v) { return __hip_atomic_fetch_add(p, v, __ATOMIC_RELAXED, __HIP_MEMORY_SCOPE_AGENT); }
__device__ __forceinline__ unsigned xb_xcc_id() { return (unsigned)__builtin_amdgcn_s_getreg((3 << 11) | 20) & 0xFu; }
#define XB_SPIN(cond, bar) do { unsigned _sp = 0; while (cond) { __builtin_amdgcn_s_sleep(1); \
    if ((++_sp & 255u) == 0u) { if (xb_ld(&(bar)[XB_TMO])) break; if (_sp > XB_SPIN_CAP) { atomicAdd(&(bar)[XB_TMO], 1u); break; } } } } while (0)
struct XcdBarrier { unsigned* bar; unsigned x; volatile LAS unsigned* st; };
__device__ __forceinline__ XcdBarrier xcd_barrier_post(unsigned* bar, volatile LAS unsigned* st) {
    XcdBarrier b; b.bar = bar; b.x = xb_xcc_id(); b.st = st;
    if (threadIdx.x == 0) (void)xb_add(&bar[XB_XCNT(b.x)], 1u);
    return b;
}
__device__ __forceinline__ void xcd_barrier_complete(unsigned* bar, unsigned x, unsigned& nloc, unsigned& nx) {
    const unsigned G = gridDim.x * gridDim.y * gridDim.z;
    unsigned sum, cnt, mine, sp = 0u;
    for (;;) {
        sum = 0u; cnt = 0u; mine = 0u;
#pragma unroll
        for (unsigned j = 0; j < 16; ++j) { const unsigned c = xb_ld(&bar[XB_XCNT(j)]); sum += c; cnt += (c > 0u) ? 1u : 0u; mine = (j == x) ? c : mine; }
        if (sum == G) break;
        __builtin_amdgcn_s_sleep(1);
        if ((++sp & 255u) == 0u) { if (xb_ld(&bar[XB_TMO])) break; if (sp > XB_SPIN_CAP) { atomicAdd(&bar[XB_TMO], 1u); break; } }
    }
    nloc = mine > 0u ? mine : 1u; nx = cnt > 0u ? cnt : 1u;
}
__device__ __forceinline__ void xcd_barrier(const XcdBarrier& b) {
    asm volatile("s_waitcnt vmcnt(0)" ::: "memory");
    __syncthreads();
    if (threadIdx.x == 0) {
        unsigned* bar = b.bar;
        __builtin_amdgcn_s_waitcnt(0);
        unsigned nloc = b.st[0], nx = b.st[1];
        if (nloc == 0u) { xcd_barrier_complete(bar, b.x, nloc, nx); b.st[0] = nloc; b.st[1] = nx; }
        const unsigned old = xb_add(&bar[XB_XSUB(b.x)], 1u);
        const unsigned gen = old / nloc;
        if (old + 1u == (gen + 1u) * nloc) {
            __builtin_amdgcn_fence(__ATOMIC_RELEASE, "agent");
            asm volatile("s_waitcnt vmcnt(0)" ::: "memory");
            const unsigned og = xb_add(&bar[XB_TOP], 1u);
            const unsigned tg = og / nx;
            if (og + 1u == (tg + 1u) * nx) xb_add(&bar[XB_TOPGEN], 1u);
            else XB_SPIN(xb_ld(&bar[XB_TOPGEN]) == tg, bar);
            __builtin_amdgcn_fence(__ATOMIC_ACQUIRE, "agent");
            xb_add(&bar[XB_XGEN(b.x)], 1u);
            asm volatile("s_waitcnt vmcnt(0)" ::: "memory");
        } else {
            XB_SPIN(xb_ld(&bar[XB_XGEN(b.x)]) == gen, bar);
            __builtin_amdgcn_fence(__ATOMIC_ACQUIRE, "agent");
            asm volatile("s_waitcnt vmcnt(0)" ::: "memory");
        }
    }
    __syncthreads();
}

constexpr int NPHASES = 2 + DEPTH * 13;

__global__ void __launch_bounds__(512, 2) mega_fwd(Args a) {
    extern __shared__ __attribute__((aligned(16))) unsigned char lds_raw[];
    LAS unsigned char* lds = (LAS unsigned char*)lds_raw;
    cg::grid_group grid = cg::this_grid();
    volatile LAS unsigned* bst = (volatile LAS unsigned*)(lds + LDS_BYTES - 16);
    if (threadIdx.x < 4) bst[threadIdx.x] = 0u;
    __syncthreads();
    const XcdBarrier xbar = xcd_barrier_post((unsigned*)a.ws + 1024, bst);
    const int G = gridDim.x;
    const int lo = a.ph_lo, hi = a.ph_hi;
    unsigned char* ws = a.ws;
    float* mods = (float*)(ws + WS_MOD); bf16_t* KC = (bf16_t*)(ws + WS_KC); unsigned* selm = (unsigned*)(ws + WS_SEL); const float* hb = (const float*)(ws + WS_HB);
    bf16_t* Wb = (bf16_t*)(ws + WS_W); bf16_t* H = (bf16_t*)(ws + WS_H); bf16_t* BIG = (bf16_t*)(ws + WS_BIG); bf16_t* Y = (bf16_t*)(ws + WS_Y);
    bf16_t* Ya = Y; bf16_t* Yb = Y + 512; bf16_t* Yc = Y + (size_t)M * YP; bf16_t* Ycmp = (bf16_t*)(ws + WS_YCMP); bf16_t* WbT = (bf16_t*)(ws + WS_WB); bf16_t* MG = BIG + (size_t)64 * MiB / 2;
    const float* x_in = a.in[0]; const float* relb = a.in[2]; const float* ln_pre = a.in[5]; const float* ln_post = a.in[6];
    enum { K_MODS, K_INIT, K_G1, K_G2, K_ROW, K_GIN, K_ATT1, K_CMP, K_ATTB, K_FUSED, K_OUT };
    for (int ph = lo; ph < hi; ++ph) {
        int kind, l = 0, i = 0;
        if (ph == 0) kind = K_MODS; else if (ph == 1) kind = K_INIT;
        else { const int r = ph - 2; l = r / 13; const int q = r - 13 * l;
            if (q < 3) { i = 0; kind = q == 0 ? K_G1 : q == 1 ? K_G2 : K_ROW; }
            else if (q < 10) { i = 1; kind = q == 3 ? K_GIN : q == 4 ? K_ATT1 : q == 5 ? K_CMP : q == 6 ? K_ATTB : q == 7 ? K_FUSED : q == 8 ? K_OUT : K_ROW; }
            else { i = 2; kind = q == 10 ? K_G1 : q == 11 ? K_G2 : K_ROW; } }
        const int nrep = NREP(kind);
        for (int rep = 0; rep < nrep; ++rep) {
        if (rep) xcd_barrier(xbar);
        if (kind == K_G1 || kind == K_G2 || kind == K_GIN || kind == K_FUSED || kind == K_OUT) {
            const int j = i >> 1;
            pg8::Gemm g; pg8::EpiGen E; pg8::StaticOrder S_;
            E.sG = BIG + (size_t)blockIdx.x * 131072; E.sM = E.sG + 65536;
            const bf16_t* Ag; const bf16_t* Bg; int Nn, Kk;
            if (kind == K_G1) { Ag = H; Bg = Wb + W_GU + (size_t)j * 5632 * DM; Nn = 5632; Kk = DM; S_.em = 2; E.O = BIG; E.ldc = FF; E.ncols = 5632; }
            else if (kind == K_G2) { Ag = BIG; Bg = Wb + W_D + (size_t)j * DM * FF; Nn = DM; Kk = FF; S_.em = 0; E.O = Y; E.ldc = DM; E.ncols = DM; }
            else if (kind == K_GIN) { Ag = H; Bg = Wb + W_IN; Nn = NIN; Kk = DM; S_.em = 0; E.O = BIG; E.ldc = QP; E.ncols = QP; }
            else if (kind == K_FUSED) { Ag = H; Bg = Wb + W_IN + (size_t)NIN * DM; Nn = DM; Kk = DM; S_.em = 5; E.O = MG; E.ldc = DM; E.ncols = DM; }
            else { Ag = MG; Bg = Wb + W_O; Nn = DM; Kk = DM; S_.em = 0; E.O = Y; E.ldc = DM; E.ncols = DM; }
            g.ld = Kk;
            S_.init(M, Nn, G, (int)blockIdx.x);
            S_.A = (const char*)Ag; S_.B = (const char*)Bg; S_.tstep = (size_t)256 * Kk * 2; S_.nt = Kk / 64;
            S_.fused = (kind == K_FUSED) ? 1 : 0;
            S_.Hh = (const char*)H; S_.Wmg = (const char*)(Wb + W_IN + (size_t)NIN * DM); S_.Yab = (const char*)Y; S_.Yc = (const char*)Yc; S_.WbT = (const char*)WbT;
            { int tq_ = threadIdx.x; asm volatile("" : "+v"(tq_)); pg8::utab_build(lds, S_, tq_); }
            pg8::TabSched T_{lds};
            pg8::gemm_phase<pg8::EpiGen>(lds, g, T_, E);
        } else if (kind == K_MODS) {
            if (G > 144) { if ((int)blockIdx.x < 72) phase_mods(lds, a.in[1], a.in[3], a.in[4], mods); else phase_conv(lds, a, 0, 72, G - 72); }
            else { phase_mods(lds, a.in[1], a.in[3], a.in[4], mods); phase_conv(lds, a, 0, 0, G); }
        } else if (kind == K_INIT || kind == K_ROW) {
            const bool init = (kind == K_INIT);
            const bool last = (!init && l == DEPTH - 1 && i == 2);
            const int ln_ = init ? 0 : (i == 2 ? l + 1 : l), in_ = init ? 0 : (i == 2 ? 0 : i + 1);
            if (!init && i == 2 && !last) phase_conv(lds, a, l + 1, 0, G);
            const bool first = init || (l == 0 && i == 0), l3i1 = (!init && l == DEPTH - 1 && i == 1);
            const void* xs_ = first ? (const void*)x_in : last ? (const void*)Yc : (const void*)a.out;
            void* xd_ = l3i1 ? (void*)Yc : (void*)a.out;
            phase_rowwise(xs_, !first, xd_, !last, Y, H, mods, l, i, ln_post + ((size_t)l * 3 + i) * DM, i == 1 ? 1.0f : 0.5f, last ? 0 : ln_, in_, ln_pre + ((size_t)(last ? 0 : ln_) * 3 + in_) * DM, !init, !last);
        } else if (kind == K_ATT1) {
            {
                LAS float* lt = (LAS float*)(lds + AW_LUT);
                int t0_ = threadIdx.x; asm volatile("" : "+v"(t0_));
                for (int e = t0_; e < 8 * 128; e += 512) lt[e] = relb[(int)T5B[e & 127] * 16 + (e >> 7)] * 1.4426950408889634f;
                __syncthreads();
            }
            int t1_ = threadIdx.x; asm volatile("" : "+v"(t1_));
            const int wv = blockIdx.x * 8 + __builtin_amdgcn_readfirstlane(t1_ >> 6), NWV = G * 8;
            (void)wv; (void)NWV;
            unsigned* qctr = (unsigned*)a.ws + 8192 + ph;
            for (;;) {
                unsigned v_ = 0u; if ((t1_ & 63) == 0) v_ = atomicAdd(qctr, 1u);
                const int it = (int)__builtin_amdgcn_readfirstlane(v_);
                if (it >= 1024 + 8192 + 8192) break;
                if (it < 1024) item_cmpk(BIG, Wb, hb, KC, it >> 3, it & 7);
                else if (it < 1024 + 8192) attn_wave<MODE_C>(lds, BIG, Yc, nullptr, it - 1024);
                else attn_wave<MODE_A>(lds, BIG, Ya, a.in[11] + l * 8, it - 1024 - 8192);
            }
        } else if (kind == K_CMP) {
            for (int it = blockIdx.x; it < 1024; it += G) item_attn_cmp(lds, BIG, KC, Ycmp, selm, it);
        } else {
            unsigned* qctr = (unsigned*)a.ws + 8192 + ph;
            volatile LAS unsigned* qslot = (volatile LAS unsigned*)(lds + LDS_BYTES - 32);
            for (;;) {
                __syncthreads();
                if (threadIdx.x == 0) qslot[0] = atomicAdd(qctr, 1u);
                __syncthreads();
                const int it = (int)qslot[0];
                if (it >= 2048) break;
                item_attn_b(lds, BIG, Yb, Ycmp, relb, selm, it);
            }
        }
        __syncthreads();
        }
        if (ph + 1 < hi) { if (ph == 0) grid.sync(); else xcd_barrier(xbar); }
    }
}

extern "C" void kernel_launch(void* const* d_in, const int* in_sizes, int n_in, void* d_out, int out_size, void* d_ws, size_t ws_size, hipStream_t stream) {
    static int grid = 0;
    if (grid == 0) {
        if (n_in != 17 || in_sizes[0] != M * DM || out_size != M * DM || ws_size < WS_END) { fprintf(stderr, "kernel_launch: unexpected shapes / workspace (n_in %d ws %zu)\n", n_in, ws_size); grid = -1; return; }
        int dev = 0, cus = 0, per_cu = 0;
        (void)hipGetDevice(&dev); (void)hipDeviceGetAttribute(&cus, hipDeviceAttributeMultiprocessorCount, dev);
        (void)hipFuncSetAttribute((const void*)mega_fwd, hipFuncAttributeMaxDynamicSharedMemorySize, LDS_BYTES);
        (void)hipOccupancyMaxActiveBlocksPerMultiprocessor(&per_cu, (const void*)mega_fwd, 512, LDS_BYTES);
        if (per_cu < 1) per_cu = 1;
        grid = cus * per_cu;
        (void)hipGetLastError();
    }
    if (grid < 0) return;
    if (hipMemsetAsync(d_ws, 0, 65536, stream) != hipSuccess) { fprintf(stderr, "kernel_launch: memset of barrier words failed\n"); return; }
    Args a{};
    for (int i = 0; i < 17; ++i) a.in[i] = (const float*)d_in[i];
    a.out = (float*)d_out; a.ws = (unsigned char*)d_ws;
#if MK_PER_PHASE_LAUNCH
    for (int p = 0; p < NPHASES; ++p) { a.ph_lo = p; a.ph_hi = p + 1; hipLaunchKernelGGL(mega_fwd, dim3(grid), dim3(512), LDS_BYTES, stream, a); }
#else
    a.ph_lo = 0; a.ph_hi = NPHASES;
    void* args[] = {&a};
    hipError_t e = hipLaunchCooperativeKernel((const void*)mega_fwd, dim3(grid), dim3(512), args, LDS_BYTES, stream);
    if (e != hipSuccess) fprintf(stderr, "cooperative launch failed: %s (grid %d)\n", hipGetErrorString(e), grid);
#endif
}
```

```cpp
#include <hip/hip_runtime.h>
#include <hip/hip_cooperative_groups.h>
#include <cstdio>
#include <cstdint>
namespace cg = cooperative_groups;

#ifndef MK_PER_PHASE_LAUNCH
#define MK_PER_PHASE_LAUNCH 0
#endif

#ifndef PHMASK
#define PHMASK 0xFFFF
#endif
#define PHON(k) ((PHMASK >> (k)) & 1)
#ifndef REPMASK
#define REPMASK 0
#endif
#define NREP(k) (1 + ((REPMASK >> (k)) & 1))
#define LAS __attribute__((address_space(3)))
typedef unsigned short bf16_t;
typedef short bf16x8 __attribute__((ext_vector_type(8)));
typedef float f32x4 __attribute__((ext_vector_type(4)));
typedef float f32x2 __attribute__((ext_vector_type(2)));
typedef unsigned u32x4 __attribute__((ext_vector_type(4)));
typedef unsigned u32x2 __attribute__((ext_vector_type(2)));
typedef __bf16 bf16x2_t __attribute__((ext_vector_type(2)));

constexpr int BATCH = 32, SEQ = 2048, DM = 1024, M = BATCH * SEQ, DEPTH = 4, FF = 2816;
constexpr int INW = 6680;
constexpr int QP = 3608;
constexpr int NIN = 3840;
constexpr int NMG = 3072;
constexpr float EPS = 1e-6f;
constexpr int C_AQ = 0, C_AK = 512, C_AV = 640, C_BQ = 768, C_BKC = 1280, C_BVC = 1408, C_BKS = 1536, C_BVS = 1664, C_BKW = 1792, C_BVW = 1920,
              C_CQ = 2048, C_CK = 2560, C_CV = 3072, C_BG = 3584;
constexpr size_t MiB = 1u << 20;
constexpr size_t WS_MOD = 1 * MiB;
constexpr size_t WS_KC = 6 * MiB;
constexpr size_t WS_SEL = 8 * MiB;
constexpr size_t WS_HB = 9 * MiB;
constexpr size_t WS_W = 10 * MiB;
constexpr size_t WS_H = 64 * MiB;
constexpr size_t WS_BIG = 192 * MiB;
constexpr size_t WS_Y = 644 * MiB;
constexpr size_t WS_YCMP = 900 * MiB;
constexpr size_t WS_WB = 964 * MiB;
constexpr size_t WS_END = 970 * MiB;
constexpr int YP = 1024;
constexpr size_t W_GU = 0, W_D = 11534336, W_IN = 17301504, W_B = 24379392, W_O = 25952256, W_1 = 27000832, W_2 = 27525120;

constexpr int LDS_BYTES = 147456;

__device__ __constant__ unsigned char T5B[128] = {0, 1, 2, 3, 4, 5, 6, 7, 8, 9, 10, 11, 12, 13, 14, 15, 16, 16, 16, 17, 17, 18, 18, 18, 19, 19, 19, 20, 20, 20, 20, 21, 21, 21, 21, 22, 22, 22, 22, 22, 23, 23, 23, 23, 23, 23, 24, 24, 24, 24, 24, 24, 25, 25, 25, 25, 25, 25, 25, 26, 26, 26, 26, 26, 26, 26, 26, 27, 27, 27, 27, 27, 27, 27, 27, 27, 27, 28, 28, 28, 28, 28, 28, 28, 28, 28, 28, 29, 29, 29, 29, 29, 29, 29, 29, 29, 29, 29, 29, 30, 30, 30, 30, 30, 30, 30, 30, 30, 30, 30, 30, 30, 30, 31, 31, 31, 31, 31, 31, 31, 31, 31, 31, 31, 31, 31, 31, 31};

__device__ __forceinline__ unsigned cvtpk(float lo, float hi) { f32x2 v = {lo, hi}; bf16x2_t b = __builtin_convertvector(v, bf16x2_t); return __builtin_bit_cast(unsigned, b); }
__device__ __forceinline__ float bf2f(unsigned short u) { return __uint_as_float((unsigned)u << 16); }
__device__ __forceinline__ float bflo(unsigned u) { return __uint_as_float(u << 16); }
__device__ __forceinline__ float bfhi(unsigned u) { return __uint_as_float(u & 0xffff0000u); }
__device__ __forceinline__ float fast_rcp(float x) { return __builtin_amdgcn_rcpf(x); }
__device__ __forceinline__ float sigmoidf_(float x) { return fast_rcp(1.f + __expf(-x)); }

namespace pg8 {
constexpr int BM = 256, BK = 64, HALF = 128, HTB = HALF * BK * 2, STAGE_BYTES = 8 * HTB, NXCD = 8, WGM = 8;
__host__ __device__ __forceinline__ int lds_byte(int r, int c) { const int st = (r >> 4) * 2 + (c >> 5), rr = r & 15, cc = c & 31, ob = rr * 64 + cc * 2; return st * 1024 + (ob ^ (((ob >> 9) & 1) << 5)); }
__host__ __device__ __forceinline__ void stage_rc(int b, int& R, int& C) { const int st = b / 1024, sb = b % 1024, swz = sb ^ (((sb >> 9) & 1) << 5); R = (st >> 1) * 16 + swz / 64; C = (st & 1) * 32 + (swz % 64) / 2; }
__host__ __device__ __forceinline__ int perm32(int rho) { const int n = rho >> 4, i = rho & 15; return 8 * (i >> 2) + 4 * n + (i & 3); }
struct Unit { const char* A; const char* B; int nt; int pm, pn; int em, br; };
struct Gemm { int ld; };
struct StaticOrder {
    int nM, nN, nwg, G, c; int fused; const char* A; const char* B; size_t tstep; int nt; int em;
    const char* Hh; const char* Wmg; const char* Yab; const char* Yc; const char* WbT;
    __device__ void init(int M_, int N_, int G_, int c_) { nM = M_ / BM; nN = N_ / BM; nwg = nM * nN; G = G_; c = c_; fused = 0; }
    __device__ __forceinline__ bool tile(long L, int& pm, int& pn) const {
        if (L >= nwg) return false;
        int wgid = (int)L; { const int q = nwg / NXCD, r = nwg % NXCD, xcd = wgid % NXCD, off = wgid / NXCD; wgid = (xcd < r ? xcd * (q + 1) : r * (q + 1) + (xcd - r) * q) + off; }
        const int nig = WGM * nN, gid = wgid / nig, fm = gid * WGM, gsz = (nM - fm) < WGM ? (nM - fm) : WGM;
        pm = fm + ((wgid % nig) % gsz); pn = (wgid % nig) / gsz; return true;
    }
    __device__ __forceinline__ bool next(int i, Unit& u) const {
        if (!fused) {
            if (!tile((long)i * G + c, u.pm, u.pn)) return false;
            u.A = A + (size_t)u.pm * tstep; u.B = B + (size_t)u.pn * tstep; u.nt = nt; u.em = em; u.br = 0; return true;
        }
        const int t = i / 6, sub = i - 6 * t;
        if (!tile((long)t * G + c, u.pm, u.pn)) return false;
        const int br = sub >> 1; u.br = br;
        if ((sub & 1) == 0) { u.A = Hh + (size_t)u.pm * tstep; u.B = Wmg + (size_t)(br * 4 + u.pn) * tstep; u.nt = 16; u.em = 5; }
        else { u.A = (br == 0 ? Yab : br == 1 ? Yab + 512 * 2 : Yc) + (size_t)u.pm * tstep; u.B = WbT + (size_t)(br * 4 + u.pn) * tstep; u.nt = 8; u.em = 6; }
        return true;
    }
};
struct EpiGen {
    bf16_t* O; int ldc; int ncols; bf16_t* sG; bf16_t* sM;
    __device__ __forceinline__ void operator()(const f32x4 (&acc)[2][2][4][2], const Unit& u, int wr, int wc, int fr, int fq) const {
        const int mode = u.em;
        int fr_ = fr; asm volatile("" : "+v"(fr_));
        const int rl0 = wr * 64 + fr_, cl0 = wc * 32 + 8 * fq;
        if (mode == 2) {
            const int par = fq & 1;
#pragma unroll
            for (int ai = 0; ai < 2; ++ai)
#pragma unroll
                for (int bj = 0; bj < 2; ++bj) { const int acol = ((u.pn * BM + bj * HALF + wc * 32) >> 1) + 4 * (fq - par);
#pragma unroll
                    for (int mp = 0; mp < 4; mp += 2) {
                        u32x2 wk[2];
#pragma unroll
                        for (int q = 0; q < 2; ++q) { const f32x4 v0 = acc[ai][bj][mp + q][0], v1 = acc[ai][bj][mp + q][1]; float r[4];
#pragma unroll
                            for (int e = 0; e < 4; ++e) r[e] = v0[e] * sigmoidf_(v0[e]) * v1[e];
                            wk[q].x = cvtpk(r[0], r[1]); wk[q].y = cvtpk(r[2], r[3]); }
                        const auto sx = __builtin_amdgcn_permlane16_swap(wk[0].x, wk[1].x, false, false);
                        const auto sy = __builtin_amdgcn_permlane16_swap(wk[0].y, wk[1].y, false, false);
                        u32x4 w; w.x = sx[0]; w.y = sy[0]; w.z = sx[1]; w.w = sy[1];
                        const size_t row = (size_t)(u.pm * BM + rl0 + ai * HALF + (mp + par) * 16);
                        *(u32x4*)(O + row * ldc + acol) = w; } }
            return;
        }
#pragma unroll
        for (int ai = 0; ai < 2; ++ai)
#pragma unroll
            for (int m = 0; m < 4; ++m) { const int rl = rl0 + ai * HALF + m * 16; const size_t row = (size_t)(u.pm * BM + rl); bf16_t* rowp = O + row * ldc;
#pragma unroll
                for (int bj = 0; bj < 2; ++bj) { const int cl = cl0 + bj * HALF; const int col0 = u.pn * BM + cl; f32x4 v0 = acc[ai][bj][m][0], v1 = acc[ai][bj][m][1];
                    if (mode == 2) {
                        float r[4];
#pragma unroll
                        for (int e = 0; e < 4; ++e) r[e] = v0[e] * sigmoidf_(v0[e]) * v1[e];
                        u32x2 w; w.x = cvtpk(r[0], r[1]); w.y = cvtpk(r[2], r[3]);
                        *(u32x2*)(rowp + (col0 >> 1)) = w;
                    } else {
                        if (mode == 1 || mode == 5) {
#pragma unroll
                            for (int e = 0; e < 4; ++e) { v0[e] = sigmoidf_(v0[e]); v1[e] = sigmoidf_(v1[e]); } }
                        if (mode == 6) {
                            const u32x4 gq = *(const u32x4*)(sG + rl * 256 + cl);
                            v0[0] *= bflo(gq.x); v0[1] *= bfhi(gq.x); v0[2] *= bflo(gq.y); v0[3] *= bfhi(gq.y); v1[0] *= bflo(gq.z); v1[1] *= bfhi(gq.z); v1[2] *= bflo(gq.w); v1[3] *= bfhi(gq.w);
                            if (u.br > 0) { const u32x4 mo = *(const u32x4*)(sM + rl * 256 + cl);
                                v0[0] += bflo(mo.x); v0[1] += bfhi(mo.x); v0[2] += bflo(mo.y); v0[3] += bfhi(mo.y); v1[0] += bflo(mo.z); v1[1] += bfhi(mo.z); v1[2] += bflo(mo.w); v1[3] += bfhi(mo.w); } }
                        u32x4 w; w.x = cvtpk(v0[0], v0[1]); w.y = cvtpk(v0[2], v0[3]); w.z = cvtpk(v1[0], v1[1]); w.w = cvtpk(v1[2], v1[3]);
                        if (mode == 5) *(u32x4*)(sG + rl * 256 + cl) = w;
                        else if (mode == 6 && u.br < 2) *(u32x4*)(sM + rl * 256 + cl) = w;
                        else if (col0 < ncols) *(u32x4*)(rowp + col0) = w; } } }
    }
};

constexpr int UTAB_OFF = 131072, UTAB_MAX = 64;
__device__ __forceinline__ void utab_build(LAS unsigned char* lds, const StaticOrder& S, int tid) {
    if (tid < UTAB_MAX) { Unit u; u.A = nullptr; u.B = nullptr; u.nt = 0; u.pm = 0; u.pn = 0; u.em = 0; u.br = 0; const bool ok = S.next(tid, u);
        LAS unsigned* e = (LAS unsigned*)(lds + UTAB_OFF + tid * 32); const unsigned long long a = (unsigned long long)(uintptr_t)u.A, b = (unsigned long long)(uintptr_t)u.B;
        e[0] = (unsigned)a; e[1] = (unsigned)(a >> 32); e[2] = (unsigned)b; e[3] = (unsigned)(b >> 32); e[4] = ok ? (unsigned)u.nt : 0u; e[5] = (unsigned)u.pm; e[6] = (unsigned)u.pn; e[7] = (unsigned)(u.em | (u.br << 8)); }
    __syncthreads();
}
struct TabSched {
    LAS unsigned char* lds;
    __device__ __forceinline__ bool next(int i, Unit& u) const {
        if (i >= UTAB_MAX) return false;
        const LAS unsigned* e = (const LAS unsigned*)(lds + UTAB_OFF + i * 32);
        const u32x4 lo = *(const LAS u32x4*)e, hi = *(const LAS u32x4*)(e + 4);
        const unsigned nt = __builtin_amdgcn_readfirstlane(hi.x); if (nt == 0u) return false;
        const unsigned a0 = __builtin_amdgcn_readfirstlane(lo.x), a1 = __builtin_amdgcn_readfirstlane(lo.y), b0 = __builtin_amdgcn_readfirstlane(lo.z), b1 = __builtin_amdgcn_readfirstlane(lo.w);
        u.A = (const char*)(uintptr_t)(((unsigned long long)a1 << 32) | a0); u.B = (const char*)(uintptr_t)(((unsigned long long)b1 << 32) | b0);
        u.nt = (int)nt; u.pm = (int)__builtin_amdgcn_readfirstlane(hi.y); u.pn = (int)__builtin_amdgcn_readfirstlane(hi.z);
        const unsigned eb = __builtin_amdgcn_readfirstlane(hi.w); u.em = (int)(eb & 255u); u.br = (int)(eb >> 8); return true;
    }
};
template <class Epi>
__device__ __forceinline__ void gemm_phase(LAS unsigned char* lds, const Gemm g, const TabSched& S, const Epi& E) {
    int tid_ = threadIdx.x; asm volatile("" : "+v"(tid_));
    const int tid = tid_, wid = __builtin_amdgcn_readfirstlane(tid >> 6), lane = tid & 63, wr = wid >> 2, wc = wid & 3, fr = lane & 15, fq = lane >> 4;
    const int K = g.ld;
    unsigned voffA[2], voffB[2];
#pragma unroll
    for (int i = 0; i < 2; ++i) { int R, C; stage_rc(tid * 16 + i * 8192, R, C); const int Rb = (R & ~31) + perm32(R & 31);
        voffA[i] = (unsigned)(R * K + C) * 2u; voffB[i] = (unsigned)(Rb * K + C) * 2u; }
    const size_t kstep = (size_t)(BK * 2);
    const size_t hstep = (size_t)HALF * K * 2;
    const unsigned ldsw = (unsigned)wid * 1024u;
    const int aoff = lds_byte(wr * 64 + fr, fq * 8), boff = lds_byte(wc * 32 + fr, fq * 8);
#define PG8_SA(b, h) (((b) * 2 + (h)) * HTB)
#define PG8_SB(b, h) ((4 + (b) * 2 + (h)) * HTB)
#define PG8_STAGE(bufoff, gbase, voff) do { _Pragma("unroll") for (int _i = 0; _i < 2; ++_i) \
        __builtin_amdgcn_global_load_lds((const unsigned*)((const char*)(gbase) + (voff)[_i]), (LAS unsigned*)(lds + (bufoff) + ldsw + _i * 8192), 16, 0, 0); } while (0)
#define PG8_LDA(dst, b, h) do { _Pragma("unroll") for (int m = 0; m < 4; ++m) _Pragma("unroll") for (int k = 0; k < 2; ++k) dst[m][k] = *(const LAS bf16x8*)(lds + PG8_SA(b, h) + aoff + m * 2048 + k * 1024); } while (0)
#define PG8_LDB(dst, b, h) do { _Pragma("unroll") for (int n = 0; n < 2; ++n) _Pragma("unroll") for (int k = 0; k < 2; ++k) dst[n][k] = *(const LAS bf16x8*)(lds + PG8_SB(b, h) + boff + n * 2048 + k * 1024); } while (0)
#define PG8_MMA(ai, bj, At, Bt) do { __builtin_amdgcn_s_setprio(1); _Pragma("unroll") for (int m = 0; m < 4; ++m) _Pragma("unroll") for (int n = 0; n < 2; ++n) _Pragma("unroll") for (int k = 0; k < 2; ++k) \
        acc[ai][bj][m][n] = __builtin_amdgcn_mfma_f32_16x16x32_bf16(Bt[n][k], At[m][k], acc[ai][bj][m][n], 0, 0, 0); __builtin_amdgcn_s_setprio(0); } while (0)
#define PG8_WAIT_V(n) asm volatile("s_waitcnt vmcnt(" #n ")" ::: "memory")
#define PG8_WAIT_L(n) asm volatile("s_waitcnt lgkmcnt(" #n ")" ::: "memory")
#define PG8_BAR __builtin_amdgcn_s_barrier()
#define PG8_SCHED __builtin_amdgcn_sched_barrier(0)
    Unit cur, nxt; int ui = 0;
    if (!S.next(0, cur)) return;
    f32x4 acc[2][2][4][2];
#pragma unroll
    for (int a = 0; a < 2; ++a)
#pragma unroll
        for (int b = 0; b < 2; ++b)
#pragma unroll
            for (int m = 0; m < 4; ++m)
#pragma unroll
                for (int n = 0; n < 2; ++n) acc[a][b][m][n] = (f32x4){0.f, 0.f, 0.f, 0.f};
    bf16x8 At[4][2], B0[2][2], B1[2][2];
    const char* cA = cur.A; const char* cB = cur.B;
    PG8_STAGE(PG8_SB(0, 0), cB, voffB); PG8_STAGE(PG8_SB(0, 1), cB + hstep, voffB); PG8_STAGE(PG8_SA(0, 0), cA, voffA); PG8_STAGE(PG8_SA(0, 1), cA + hstep, voffA);
    if (wr == 1) PG8_BAR;
    PG8_WAIT_V(2); PG8_BAR;
    PG8_STAGE(PG8_SB(1, 0), cB + kstep, voffB); PG8_STAGE(PG8_SA(1, 0), cA + kstep, voffA); PG8_STAGE(PG8_SB(1, 1), cB + hstep + kstep, voffB);
    PG8_WAIT_V(6); PG8_BAR;
    for (;;) {
        const bool has_next = S.next(ui + 1, nxt);
        const char* nA = has_next ? nxt.A : cA; const char* nB = has_next ? nxt.B : cB;
        const int nt = cur.nt;
        for (int t = 0; t < nt; t += 2) {
            const bool last = (t == nt - 2);
            const char* a1 = cA + (size_t)(t + 1) * kstep;
            const char* a2 = last ? nA : cA + (size_t)(t + 2) * kstep; const char* b2 = last ? nB : cB + (size_t)(t + 2) * kstep;
            const char* a3 = a2 + kstep; const char* b3 = b2 + kstep;
            PG8_LDB(B0, 0, 0); PG8_LDB(B1, 0, 1); PG8_SCHED; PG8_LDA(At, 0, 0); PG8_STAGE(PG8_SA(1, 1), a1 + hstep, voffA);
            PG8_WAIT_V(8); PG8_WAIT_L(0); PG8_BAR; PG8_MMA(0, 0, At, B0); PG8_MMA(0, 1, At, B1); PG8_BAR; PG8_SCHED;
            PG8_LDA(At, 0, 1); PG8_STAGE(PG8_SB(0, 0), b2, voffB); PG8_STAGE(PG8_SB(0, 1), b2 + hstep, voffB); PG8_STAGE(PG8_SA(0, 0), a2, voffA);
            PG8_WAIT_V(8); PG8_WAIT_L(0); PG8_BAR; PG8_MMA(1, 0, At, B0); PG8_MMA(1, 1, At, B1); PG8_BAR; PG8_SCHED;
            PG8_LDB(B0, 1, 0); PG8_LDB(B1, 1, 1); PG8_SCHED; PG8_LDA(At, 1, 0); PG8_STAGE(PG8_SA(0, 1), a2 + hstep, voffA);
            PG8_WAIT_V(8); PG8_WAIT_L(0); PG8_BAR; PG8_MMA(0, 0, At, B0); PG8_MMA(0, 1, At, B1); PG8_BAR; PG8_SCHED;
            PG8_LDA(At, 1, 1); PG8_STAGE(PG8_SB(1, 0), b3, voffB); PG8_STAGE(PG8_SB(1, 1), b3 + hstep, voffB); PG8_STAGE(PG8_SA(1, 0), a3, voffA);
            PG8_WAIT_V(8); PG8_WAIT_L(0); PG8_BAR; PG8_MMA(1, 0, At, B0); PG8_MMA(1, 1, At, B1); PG8_BAR; PG8_SCHED;
        }
        if (wr == 0) PG8_BAR;
        E(acc, cur, wr, wc, fr, fq);
        if (!has_next) break;
#pragma unroll
        for (int a = 0; a < 2; ++a)
#pragma unroll
            for (int b = 0; b < 2; ++b)
#pragma unroll
                for (int m = 0; m < 4; ++m)
#pragma unroll
                    for (int n = 0; n < 2; ++n) acc[a][b][m][n] = (f32x4){0.f, 0.f, 0.f, 0.f};
        cur = nxt; cA = nA; cB = nB; ++ui;
        if (wr == 1) PG8_BAR;
    }
    PG8_WAIT_V(0);
    PG8_BAR;
#undef PG8_SA
#undef PG8_SB
#undef PG8_STAGE
#undef PG8_LDA
#undef PG8_LDB
#undef PG8_MMA
#undef PG8_WAIT_V
#undef PG8_WAIT_L
#undef PG8_BAR
#undef PG8_SCHED
}
}

struct Args {
    const float* in[17]; float* out; unsigned char* ws; int ph_lo, ph_hi;
};

__device__ __forceinline__ void phase_mods(LAS unsigned char* lds, const float* c, const float* ada_w, const float* ada_b, float* mods, int nwg) {
    LAS float* sc = (LAS float*)lds;
    LAS float* red = (LAS float*)(lds + 131072);
    int tid_ = threadIdx.x; asm volatile("" : "+v"(tid_)); const int tid = tid_;
    for (int e = tid; e < 32 * 1024; e += 512) { const int b = e >> 10, k = e & 1023; const float v = c[e]; sc[k * 32 + b] = v * sigmoidf_(v); }
    __syncthreads();
    constexpr int NCOLT = DEPTH * 9216;
    const int cl = tid & 255, kh = tid >> 8;
    for (int it = blockIdx.x; it < NCOLT / 256; it += nwg) {
        const int n = it * 256 + cl, l = n / 9216, col = n % 9216;
        const float* w = ada_w + (size_t)l * 1024 * 9216 + col + (size_t)kh * 512 * 9216;
        const LAS float* scp = sc + kh * 512 * 32;
        float acc[32];
#pragma unroll
        for (int b = 0; b < 32; ++b) acc[b] = 0.f;
#pragma unroll 4
        for (int k = 0; k < 512; ++k) { const float wv = w[(size_t)k * 9216];
#pragma unroll
            for (int q = 0; q < 8; ++q) { const f32x4 cv = *(const LAS f32x4*)(scp + k * 32 + q * 4); acc[q * 4 + 0] += wv * cv.x; acc[q * 4 + 1] += wv * cv.y; acc[q * 4 + 2] += wv * cv.z; acc[q * 4 + 3] += wv * cv.w; } }
        const float bb = ada_b[l * 9216 + col];
#pragma unroll
        for (int r = 0; r < 4; ++r) {
            if (kh == 1) {
#pragma unroll
                for (int j = 0; j < 8; ++j) red[cl * 8 + j] = acc[8 * r + j]; }
            __syncthreads();
            if (kh == 0) {
#pragma unroll
                for (int j = 0; j < 8; ++j) mods[((size_t)l * 32 + 8 * r + j) * 9216 + col] = acc[8 * r + j] + red[cl * 8 + j] + bb; }
            __syncthreads();
        }
    }
    __syncthreads();
}

__device__ __forceinline__ int wmap(int mode, int n) {
    if (mode == 0) return n;
    if (mode == 1) return ((n >> 2) << 3) + (n & 3);
    if (mode == 2) return ((n >> 2) << 3) + 4 + (n & 3);
    if (n < 2048) return n;
    if (n < 2072) return C_BG + (n - 2048);
    if (n < 3608) return n - 24;
    return NIN + (n - 3608);
}
__device__ __forceinline__ void tr_item(const float* W, int K, int N, bf16_t* WT, int mode, LAS float* scr, int item, int lane, int ldT = 0) {
    if (ldT == 0) ldT = K;
    const int nblk = (N + 31) / 32, kb = item / nblk, nb = item % nblk, k0 = 64 * kb, n0 = 32 * nb;
    const int qn = n0 + 4 * (lane & 7); const bool ok = qn < N;
#pragma unroll
    for (int i = 0; i < 8; ++i) { const int kk = 8 * i + (lane >> 3); const f32x4 v = ok ? *(const f32x4*)(W + (size_t)(k0 + kk) * N + qn) : (f32x4){0.f, 0.f, 0.f, 0.f};
        LAS float* d = scr + kk * 33 + 4 * (lane & 7); d[0] = v.x; d[1] = v.y; d[2] = v.z; d[3] = v.w; }
    asm volatile("s_waitcnt lgkmcnt(0)" ::: "memory");
    const int c = lane & 7;
#pragma unroll
    for (int j = 0; j < 4; ++j) { const int n = (lane >> 3) + 8 * j; const LAS float* s = scr + (8 * c) * 33 + n;
        u32x4 o; o.x = cvtpk(s[0 * 33], s[1 * 33]); o.y = cvtpk(s[2 * 33], s[3 * 33]); o.z = cvtpk(s[4 * 33], s[5 * 33]); o.w = cvtpk(s[6 * 33], s[7 * 33]);
        if (n0 + n < N) *(u32x4*)(WT + (size_t)wmap(mode, n0 + n) * ldT + k0 + 8 * c) = o; }
    asm volatile("s_waitcnt lgkmcnt(0)" ::: "memory");
}
__device__ __forceinline__ void phase_conv(LAS unsigned char* lds, const Args& a, int l, int wg0, int nwg) {
    int tid_ = threadIdx.x; asm volatile("" : "+v"(tid_));
    const int lane = tid_ & 63, wid = __builtin_amdgcn_readfirstlane(tid_ >> 6), gw = ((int)blockIdx.x - wg0) * 8 + wid, NGW = nwg * 8;
    LAS float* scr = (LAS float*)(lds + wid * 8704);
    bf16_t* Wb = (bf16_t*)(a.ws + WS_W);
    const float* wg = a.in[7] + (size_t)l * 2 * DM * FF; const float* wu = a.in[8] + (size_t)l * 2 * DM * FF; const float* wd = a.in[9] + (size_t)l * 2 * FF * DM;
    const float* win = a.in[10] + (size_t)l * DM * INW; const float* w1 = a.in[13] + (size_t)l * 2 * 2048 * 128; const float* w2 = a.in[14] + (size_t)l * 2 * 128 * 64;
    const float* wb = a.in[15] + (size_t)l * 3 * 512 * DM; const float* wo = a.in[16] + (size_t)l * DM * DM;
    constexpr int I_G = (DM / 64) * (FF / 32), I_D = (FF / 64) * (DM / 32), I_IN = (DM / 64) * ((INW + 31) / 32), I_B = (512 / 64) * (DM / 32), I_O = (DM / 64) * (DM / 32),
                  I_1 = (2048 / 64) * (128 / 32), I_2 = (128 / 64) * (64 / 32);
    constexpr int NITEMS = 4 * I_G + 2 * I_D + I_IN + 3 * I_B + I_O + 2 * I_1 + 2 * I_2;
    for (int it = gw; it < NITEMS; it += NGW) {
        int r = it;
        if (r < 4 * I_G) { const int j = r / (2 * I_G), gu = (r / I_G) & 1; tr_item((gu ? wu : wg) + (size_t)j * DM * FF, DM, FF, Wb + W_GU + (size_t)j * 5632 * DM, 1 + gu, scr, r % I_G, lane); continue; } r -= 4 * I_G;
        if (r < 2 * I_D) { const int j = r / I_D; tr_item(wd + (size_t)j * FF * DM, FF, DM, Wb + W_D + (size_t)j * DM * FF, 0, scr, r % I_D, lane); continue; } r -= 2 * I_D;
        if (r < I_IN) { tr_item(win, DM, INW, Wb + W_IN, 3, scr, r, lane); continue; } r -= I_IN;
        if (r < 3 * I_B) { const int j = r / I_B; tr_item(wb + (size_t)j * 512 * DM, 512, DM, (bf16_t*)(a.ws + WS_WB) + (size_t)j * DM * 1024, 0, scr, r % I_B, lane, 1024); continue; } r -= 3 * I_B;
        if (r < I_O) { tr_item(wo, DM, DM, Wb + W_O, 0, scr, r, lane); continue; } r -= I_O;
        if (r < 2 * I_1) { const int j = r / I_1; tr_item(w1 + (size_t)j * 2048 * 128, 2048, 128, Wb + W_1 + (size_t)j * 128 * 2048, 0, scr, r % I_1, lane); continue; } r -= 2 * I_1;
        { const int j = r / I_2; tr_item(w2 + (size_t)j * 128 * 64, 128, 64, Wb + W_2 + (size_t)j * 64 * 128, 0, scr, r % I_2, lane); }
    }
    { const int tot = (NIN - QP) * DM / 8; for (int e = gw * 64 + lane; e < tot; e += NGW * 64) *(u32x4*)(Wb + W_IN + (size_t)QP * DM + (size_t)e * 8) = (u32x4){0u, 0u, 0u, 0u}; }
    { const float* pos = a.in[12] + (size_t)l * 2 * 2048; float* hb = (float*)(a.ws + WS_HB);
      for (int o = gw; o < 256; o += NGW) { const int ty = o >> 7, hid = o & 127; float s = 0.f;
          for (int k = lane; k < 2048; k += 64) s += pos[ty * 2048 + k] * w1[((size_t)ty * 2048 + k) * 128 + hid];
#pragma unroll
          for (int off = 1; off < 64; off <<= 1) s += __shfl_xor(s, off);
          if (lane == 0) hb[o] = s; } }
}

__device__ __forceinline__ void phase_rowwise(const void* xsrc_, bool sbf, void* xdst_, bool dbf, const bf16_t* Y, bf16_t* H, const float* mods, int lprev, int iprev, const float* lnpost, float resw,
                                              int lnext, int inext, const float* lnpre, bool hasprev, bool hasnext) {
    int tid_ = threadIdx.x; asm volatile("" : "+v"(tid_));
    const int lane = tid_ & 63, wid = __builtin_amdgcn_readfirstlane(tid_ >> 6), gw = blockIdx.x * 8 + wid, NGW = gridDim.x * 8;
    const float* xsrc = (const float*)xsrc_; const bf16_t* xsrcb = (const bf16_t*)xsrc_; float* xdst = (float*)xdst_; bf16_t* xdstb = (bf16_t*)xdst_;
    for (int ch = gw; ch < M / 32; ch += NGW) {
        const int b = ch >> 6;
        f32x4 gp[4], na[4], ns[4];
#pragma unroll
        for (int j = 0; j < 4; ++j) { const int c = 4 * lane + 256 * j;
            if (hasprev) { const f32x4 g = *(const f32x4*)(mods + ((size_t)lprev * 32 + b) * 9216 + iprev * 3072 + 2048 + c); const f32x4 lp = *(const f32x4*)(lnpost + c); gp[j] = g * lp * resw; }
            else gp[j] = (f32x4){0.f, 0.f, 0.f, 0.f};
            if (hasnext) { const f32x4 sh = *(const f32x4*)(mods + ((size_t)lnext * 32 + b) * 9216 + inext * 3072 + c); const f32x4 scl = *(const f32x4*)(mods + ((size_t)lnext * 32 + b) * 9216 + inext * 3072 + 1024 + c);
                const f32x4 lp = *(const f32x4*)(lnpre + c); na[j] = lp * (scl + 1.0f); ns[j] = sh; }
            else { na[j] = (f32x4){0.f, 0.f, 0.f, 0.f}; ns[j] = na[j]; } }
        f32x4 xn[2][4]; u32x2 xnb[2][4]; u32x2 yn[2][4];
        { const size_t m0 = (size_t)ch * 32;
#pragma unroll
          for (int r = 0; r < 2; ++r)
#pragma unroll
            for (int j = 0; j < 4; ++j) { if (sbf) { xnb[r][j] = *(const u32x2*)(xsrcb + (m0 + r) * DM + 4 * lane + 256 * j); xn[r][j] = (f32x4){0.f, 0.f, 0.f, 0.f}; } else { xn[r][j] = *(const f32x4*)(xsrc + (m0 + r) * DM + 4 * lane + 256 * j); xnb[r][j] = (u32x2){0u, 0u}; }
                yn[r][j] = hasprev ? *(const u32x2*)(Y + (m0 + r) * DM + 4 * lane + 256 * j) : (u32x2){0u, 0u}; } }
        for (int rr = 0; rr < 32; rr += 2) {
            const size_t m = (size_t)ch * 32 + rr;
            f32x4 x[2][4]; u32x2 yr[2][4];
#pragma unroll
            for (int r = 0; r < 2; ++r)
#pragma unroll
                for (int j = 0; j < 4; ++j) { if (sbf) { const u32x2 u = xnb[r][j]; x[r][j] = (f32x4){bflo(u.x), bfhi(u.x), bflo(u.y), bfhi(u.y)}; } else x[r][j] = xn[r][j]; yr[r][j] = yn[r][j]; }
            if (rr + 2 < 32) {
#pragma unroll
                for (int r = 0; r < 2; ++r)
#pragma unroll
                    for (int j = 0; j < 4; ++j) { if (sbf) xnb[r][j] = *(const u32x2*)(xsrcb + (m + 2 + r) * DM + 4 * lane + 256 * j); else xn[r][j] = *(const f32x4*)(xsrc + (m + 2 + r) * DM + 4 * lane + 256 * j); if (hasprev) yn[r][j] = *(const u32x2*)(Y + (m + 2 + r) * DM + 4 * lane + 256 * j); } }
            if (hasprev) {
                f32x4 y[2][4]; float ss[2] = {0.f, 0.f};
#pragma unroll
                for (int r = 0; r < 2; ++r)
#pragma unroll
                    for (int j = 0; j < 4; ++j) { const u32x2 u = yr[r][j]; y[r][j] = (f32x4){bflo(u.x), bfhi(u.x), bflo(u.y), bfhi(u.y)};
                        ss[r] += (y[r][j].x * y[r][j].x + y[r][j].y * y[r][j].y) + (y[r][j].z * y[r][j].z + y[r][j].w * y[r][j].w); }
#pragma unroll
                for (int off = 1; off < 64; off <<= 1) { ss[0] += __shfl_xor(ss[0], off); ss[1] += __shfl_xor(ss[1], off); }
#pragma unroll
                for (int r = 0; r < 2; ++r) { const float rs = __builtin_amdgcn_rsqf(ss[r] * (1.f / DM) + EPS);
#pragma unroll
                    for (int j = 0; j < 4; ++j) x[r][j] = x[r][j] + gp[j] * (y[r][j] * rs); }
            }
#pragma unroll
            for (int r = 0; r < 2; ++r)
#pragma unroll
                for (int j = 0; j < 4; ++j) { if (hasprev) { if (dbf) { u32x2 w; w.x = cvtpk(x[r][j].x, x[r][j].y); w.y = cvtpk(x[r][j].z, x[r][j].w); *(u32x2*)(xdstb + (m + r) * DM + 4 * lane + 256 * j) = w; } else *(f32x4*)(xdst + (m + r) * DM + 4 * lane + 256 * j) = x[r][j]; } }
            if (hasnext) {
                float ss[2] = {0.f, 0.f};
#pragma unroll
                for (int r = 0; r < 2; ++r)
#pragma unroll
                    for (int j = 0; j < 4; ++j) ss[r] += (x[r][j].x * x[r][j].x + x[r][j].y * x[r][j].y) + (x[r][j].z * x[r][j].z + x[r][j].w * x[r][j].w);
#pragma unroll
                for (int off = 1; off < 64; off <<= 1) { ss[0] += __shfl_xor(ss[0], off); ss[1] += __shfl_xor(ss[1], off); }
#pragma unroll
                for (int r = 0; r < 2; ++r) { const float rs = __builtin_amdgcn_rsqf(ss[r] * (1.f / DM) + EPS);
#pragma unroll
                    for (int j = 0; j < 4; ++j) { const f32x4 h = (x[r][j] * rs) * na[j] + ns[j]; u32x2 w; w.x = cvtpk(h.x, h.y); w.y = cvtpk(h.z, h.w); *(u32x2*)(H + (m + r) * DM + 4 * lane + 256 * j) = w; } }
            }
        }
    }
}

#define LDS_BARRIER() asm volatile("s_waitcnt lgkmcnt(0)\n\ts_barrier" ::: "memory")
#define MFMA16(a, b, c) __builtin_amdgcn_mfma_f32_16x16x32_bf16((a), (b), (c), 0, 0, 0)
constexpr int KPB = 144;
constexpr int ATT_TILE = 9216, ATT_KS = 0, ATT_VS = 2 * ATT_TILE, ATT_LUT = 4 * ATT_TILE, ATT_FLAG = ATT_LUT + 512;
enum { MODE_A = 0, MODE_BWIN = 1, MODE_BSLC = 2, MODE_C = 3 };
typedef short v4i16_t __attribute__((ext_vector_type(4)));
__device__ __forceinline__ v4i16_t tr_read(const LAS unsigned char* p) { return __builtin_amdgcn_ds_read_tr16_b64_v4i16((LAS v4i16_t*)p); }
__device__ __forceinline__ bf16x8 vfrag(const LAS unsigned char* p) { const v4i16_t a = tr_read(p), b = tr_read(p + 16 * KPB); return (bf16x8){a[0], a[1], a[2], a[3], b[0], b[1], b[2], b[3]}; }

__device__ __forceinline__ void store_row16(bf16_t* rowp, int g, const u32x2 (&pk)[4]) {
    const int par = g & 1;
#pragma unroll
    for (int pr = 0; pr < 2; ++pr) {
        const auto sx = __builtin_amdgcn_permlane16_swap(pk[2 * pr].x, pk[2 * pr + 1].x, false, false);
        const auto sy = __builtin_amdgcn_permlane16_swap(pk[2 * pr].y, pk[2 * pr + 1].y, false, false);
        u32x4 w; w.x = sx[0]; w.y = sy[0]; w.z = sx[1]; w.w = sy[1];
        *(u32x4*)(rowp + 16 * (2 * pr + par) + 4 * (g - par)) = w; }
}

template <int MODE>
__device__ __forceinline__ void attn_pass(LAS unsigned char* lds, const bf16_t* base, int gk, int q0, const float* relb_b, const unsigned* selrow, f32x4 (&o)[2][4]) {
    int tid_ = threadIdx.x; asm volatile("" : "+v"(tid_));
    const int tid = tid_, lane = tid & 63, wid = __builtin_amdgcn_readfirstlane(tid >> 6), c = lane & 15, g = lane >> 4;
    constexpr int W = (MODE == MODE_BWIN) ? 512 : 1 << 20;
    constexpr float LOG2E = 1.4426950408889634f, C1 = 0.125f * LOG2E;
    const int hh = wid & 3, h = gk * 4 + hh;
    const bf16_t* qp = base + C_BQ + h * 64;
    const bf16_t* kp = base + (MODE == MODE_BSLC ? C_BKS : C_BKW) + gk * 64;
    const bf16_t* vp = base + (MODE == MODE_BSLC ? C_BVS : C_BVW) + gk * 64;
    LAS float* lutw = (LAS float*)(lds + ATT_LUT);
    const LAS float* lut = lutw + hh * 128;
    const int qw0 = q0 + (wid >> 2) * 32;
    bf16x8 qf[2][2];
#pragma unroll
    for (int qt = 0; qt < 2; ++qt)
#pragma unroll
        for (int ks = 0; ks < 2; ++ks) qf[qt][ks] = *(const bf16x8*)(qp + (size_t)(qw0 + qt * 16 + c) * QP + ks * 32 + g * 8);
    const int kb_hi = q0 >> 6;
    unsigned todo;
    unsigned sel[2] = {0xffffffffu, 0xffffffffu};
    unsigned selw = 0xffffffffu;
    if (MODE == MODE_BSLC) {
        sel[0] = selrow[qw0 + c]; sel[1] = selrow[qw0 + 16 + c];
        unsigned u = sel[0] | sel[1];
#pragma unroll
        for (int off = 1; off < 64; off <<= 1) u |= __shfl_xor(u, off);
        selw = __builtin_amdgcn_readfirstlane(u);
        unsigned v = selrow[q0 + lane];
#pragma unroll
        for (int off = 1; off < 64; off <<= 1) v |= __shfl_xor(v, off);
        todo = __builtin_amdgcn_readfirstlane(v) & (0xffffffffu >> (31 - kb_hi));
    } else {
        const int kb_lo = kb_hi >= 8 ? kb_hi - 8 : 0;
        todo = (0xffffffffu >> (31 - kb_hi)) & (0xffffffffu << kb_lo);
    }
    __syncthreads();
    if (tid < 512) { const int e = tid; lutw[e] = relb_b[(int)T5B[e & 127] * 16 + gk * 4 + (e >> 7)] * LOG2E; }
    const float bias_far = relb_b[31 * 16 + h] * LOG2E;
#pragma unroll
    for (int qt = 0; qt < 2; ++qt)
#pragma unroll
        for (int dt = 0; dt < 4; ++dt) o[qt][dt] = (f32x4){0.f, 0.f, 0.f, 0.f};
    float mrun[2] = {-1e30f, -1e30f}, lrun[2] = {0.f, 0.f};
    const int skey = tid >> 3, sch = tid & 7;
    const unsigned soff = skey * KPB + sch * 16;
    u32x4 kreg, vreg;
    int kb = 31 - __builtin_clz(todo); todo &= ~(1u << kb);
    { const size_t ro = (size_t)(kb * 64 + skey) * QP + sch * 8; kreg = *(const u32x4*)(kp + ro); vreg = *(const u32x4*)(vp + ro); }
    *(LAS u32x4*)(lds + ATT_KS + soff) = kreg; *(LAS u32x4*)(lds + ATT_VS + soff) = vreg;
    int kbn = todo ? 31 - __builtin_clz(todo) : -1; if (kbn >= 0) todo &= ~(1u << kbn);
    if (kbn >= 0) { const size_t ro = (size_t)(kbn * 64 + skey) * QP + sch * 8; kreg = *(const u32x4*)(kp + ro); vreg = *(const u32x4*)(vp + ro); }
    LDS_BARRIER();
    int buf = 0;
    while (kb >= 0) {
        const int kbnn = todo ? 31 - __builtin_clz(todo) : -1; if (kbnn >= 0) todo &= ~(1u << kbnn);
        if (kbn >= 0) { *(LAS u32x4*)(lds + ATT_KS + (buf ^ 1) * ATT_TILE + soff) = kreg; *(LAS u32x4*)(lds + ATT_VS + (buf ^ 1) * ATT_TILE + soff) = vreg; }
        if (kbnn >= 0) { const size_t ro = (size_t)(kbnn * 64 + skey) * QP + sch * 8; kreg = *(const u32x4*)(kp + ro); vreg = *(const u32x4*)(vp + ro); }
        const LAS unsigned char* Ks = lds + ATT_KS + buf * ATT_TILE; const LAS unsigned char* Vs = lds + ATT_VS + buf * ATT_TILE;
        const int k0 = kb * 64;
        const bool need = (MODE == MODE_BSLC) ? (((selw >> kb) & 1u) != 0u) : true;
        if (need) {
        bf16x8 kfr[4][2], vfr[4][2];
#pragma unroll
        for (int nt = 0; nt < 4; ++nt) { kfr[nt][0] = *(const LAS bf16x8*)(Ks + (16 * nt + c) * KPB + g * 16); kfr[nt][1] = *(const LAS bf16x8*)(Ks + (16 * nt + c) * KPB + 64 + g * 16); }
        { const LAS unsigned char* vb = Vs + (4 * g + (c >> 2)) * KPB + (c & 3) * 8;
#pragma unroll
          for (int dt = 0; dt < 4; ++dt)
#pragma unroll
            for (int p = 0; p < 2; ++p) vfr[dt][p] = vfrag(vb + 32 * p * KPB + dt * 32); }
        __builtin_amdgcn_sched_barrier(0);
        f32x4 s[2][4];
#pragma unroll
        for (int nt = 0; nt < 4; ++nt) {
#pragma unroll
            for (int qt = 0; qt < 2; ++qt) { f32x4 z = (f32x4){0.f, 0.f, 0.f, 0.f}; z = MFMA16(kfr[nt][0], qf[qt][0], z); s[qt][nt] = MFMA16(kfr[nt][1], qf[qt][1], z); }
        }
        const bool far = (qw0 - (k0 + 63)) >= 113;
        const bool fast = far && ((qw0 + 31 - k0) < W);
#pragma unroll
        for (int qt = 0; qt < 2; ++qt) {
            const bool selb = (MODE == MODE_BSLC) ? (((sel[qt] >> kb) & 1u) != 0u) : true;
            float mnew, alpha;
            if (fast) {
                float mx = fmaxf(fmaxf(s[qt][0][0], s[qt][0][1]), fmaxf(s[qt][0][2], s[qt][0][3]));
#pragma unroll
                for (int nt = 1; nt < 4; ++nt) mx = fmaxf(mx, fmaxf(fmaxf(s[qt][nt][0], s[qt][nt][1]), fmaxf(s[qt][nt][2], s[qt][nt][3])));
                mx = fmaxf(mx, __shfl_xor(mx, 16)); mx = fmaxf(mx, __shfl_xor(mx, 32));
                const float mxl = selb ? (mx * C1 + bias_far) : -1e30f;
                mnew = fmaxf(mrun[qt], mxl); alpha = __builtin_amdgcn_exp2f(mrun[qt] - mnew);
                const float c1 = selb ? C1 : 0.f, c2 = selb ? (bias_far - mnew) : -1e30f;
#pragma unroll
                for (int nt = 0; nt < 4; ++nt)
#pragma unroll
                    for (int j = 0; j < 4; ++j) s[qt][nt][j] = __builtin_amdgcn_exp2f(s[qt][nt][j] * c1 + c2);
            } else {
                const int dbase = selb ? (qw0 + 16 * qt + c - k0 - 4 * g) : -(1 << 22);
                float mx = -1e30f;
#pragma unroll
                for (int nt = 0; nt < 4; ++nt)
#pragma unroll
                    for (int j = 0; j < 4; ++j) { const int dist = dbase - (16 * nt + j); const bool valid = (unsigned)dist < (unsigned)W;
                        const unsigned di = (unsigned)dist < 127u ? (unsigned)dist : 127u;
                        const float lg = valid ? (s[qt][nt][j] * C1 + lut[di]) : -1e30f; s[qt][nt][j] = lg; mx = fmaxf(mx, lg); }
                mx = fmaxf(mx, __shfl_xor(mx, 16)); mx = fmaxf(mx, __shfl_xor(mx, 32));
                mnew = fmaxf(mrun[qt], mx); alpha = __builtin_amdgcn_exp2f(mrun[qt] - mnew);
#pragma unroll
                for (int nt = 0; nt < 4; ++nt)
#pragma unroll
                    for (int j = 0; j < 4; ++j) s[qt][nt][j] = __builtin_amdgcn_exp2f(s[qt][nt][j] - mnew);
            }
            float ps = 0.f;
#pragma unroll
            for (int nt = 0; nt < 4; ++nt) ps += (s[qt][nt][0] + s[qt][nt][1]) + (s[qt][nt][2] + s[qt][nt][3]);
            lrun[qt] = lrun[qt] * alpha + ps;
            if (__any(mnew > mrun[qt])) {
#pragma unroll
                for (int dt = 0; dt < 4; ++dt) o[qt][dt] = o[qt][dt] * alpha; }
            mrun[qt] = mnew;
        }
        bf16x8 pb[2][2];
#pragma unroll
        for (int qt = 0; qt < 2; ++qt)
#pragma unroll
            for (int p = 0; p < 2; ++p) { u32x4 w; w.x = cvtpk(s[qt][2 * p][0], s[qt][2 * p][1]); w.y = cvtpk(s[qt][2 * p][2], s[qt][2 * p][3]);
                w.z = cvtpk(s[qt][2 * p + 1][0], s[qt][2 * p + 1][1]); w.w = cvtpk(s[qt][2 * p + 1][2], s[qt][2 * p + 1][3]); pb[qt][p] = __builtin_bit_cast(bf16x8, w); }
#pragma unroll
        for (int dt = 0; dt < 4; ++dt)
#pragma unroll
            for (int p = 0; p < 2; ++p) {
#pragma unroll
                for (int qt = 0; qt < 2; ++qt) o[qt][dt] = MFMA16(vfr[dt][p], pb[qt][p], o[qt][dt]); }
        }
        LDS_BARRIER();
        kb = kbn; kbn = kbnn; buf ^= 1;
    }
#pragma unroll
    for (int qt = 0; qt < 2; ++qt) { float l = lrun[qt]; l += __shfl_xor(l, 16); l += __shfl_xor(l, 32);
        const float inv = 1.f / l;
#pragma unroll
        for (int dt = 0; dt < 4; ++dt) o[qt][dt] = o[qt][dt] * inv; }
}

constexpr int AW_VT = 0, AW_LUT = 8 * ATT_TILE;
template <int MODE>
__device__ __forceinline__ void attn_wave(LAS unsigned char* lds, const bf16_t* qkv, bf16_t* Yout, const float* sinks, int wi) {
    int tid_ = threadIdx.x; asm volatile("" : "+v"(tid_));
    const int lane = tid_ & 63, wid = __builtin_amdgcn_readfirstlane(tid_ >> 6), c = lane & 15, g = lane >> 4;
    constexpr float LOG2E = 1.4426950408889634f, C1 = 0.125f * LOG2E;
    constexpr int NQT = 4;
    const int qb = wi & 31, h = (wi >> 5) & 7, b = wi >> 8; const int q0 = qb * 64;
    const bf16_t* base = qkv + (size_t)b * SEQ * QP;
    const bf16_t* qp = base + (MODE == MODE_A ? C_AQ + h * 64 : C_CQ + h * 64);
    const bf16_t* kp = base + (MODE == MODE_A ? C_AK + (h >> 2) * 64 : C_CK + h * 64);
    const bf16_t* vp = base + (MODE == MODE_A ? C_AV + (h >> 2) * 64 : C_CV + h * 64);
    LAS unsigned char* Vs = lds + AW_VT + wid * ATT_TILE;
    const LAS float* lutp = (const LAS float*)(lds + AW_LUT) + h * 128;
    bf16x8 qf[NQT][2];
#pragma unroll
    for (int qt = 0; qt < NQT; ++qt)
#pragma unroll
        for (int ks = 0; ks < 2; ++ks) qf[qt][ks] = *(const bf16x8*)(qp + (size_t)(q0 + qt * 16 + c) * QP + ks * 32 + g * 8);
    f32x4 o[NQT][4];
#pragma unroll
    for (int qt = 0; qt < NQT; ++qt)
#pragma unroll
        for (int dt = 0; dt < 4; ++dt) o[qt][dt] = (f32x4){0.f, 0.f, 0.f, 0.f};
    float mrun[NQT], lrun[NQT], carry[NQT];
#pragma unroll
    for (int qt = 0; qt < NQT; ++qt) { mrun[qt] = -1e30f; lrun[qt] = 0.f; carry[qt] = 0.f; }
    const int kb_hi = (q0 + 63) >> 5;
    int kb_lo = 0;
    if (MODE == MODE_A) { const int lo = q0 - 127; kb_lo = lo > 0 ? (lo >> 5) : 0; }
    for (int kb = kb_hi; kb >= kb_lo; --kb) {
        const int k0 = kb * 32;
        u32x4 vr[4];
#pragma unroll
        for (int i = 0; i < 4; ++i) { const int e = lane + 64 * i; vr[i] = *(const u32x4*)(vp + (size_t)(k0 + (e >> 3)) * QP + (e & 7) * 8); }
        bf16x8 kf[2][2];
#pragma unroll
        for (int nt = 0; nt < 2; ++nt)
#pragma unroll
            for (int ks = 0; ks < 2; ++ks) kf[nt][ks] = *(const bf16x8*)(kp + (size_t)(k0 + 16 * nt + c) * QP + ks * 32 + g * 8);
#pragma unroll
        for (int i = 0; i < 4; ++i) { const int e = lane + 64 * i; *(LAS u32x4*)(Vs + (e >> 3) * KPB + (e & 7) * 16) = vr[i]; }
        bf16x8 vfr[4];
        { const LAS unsigned char* vb = Vs + (4 * g + (c >> 2)) * KPB + (c & 3) * 8;
#pragma unroll
          for (int dt = 0; dt < 4; ++dt) vfr[dt] = vfrag(vb + dt * 32); }
        __builtin_amdgcn_sched_barrier(0);
#pragma unroll
        for (int qt = 0; qt < NQT; ++qt) {
            bool live = (k0 <= q0 + 16 * qt + 15);
            if (MODE == MODE_A) live = live && (q0 + 16 * qt - (k0 + 31) < 128);
            if (MODE == MODE_C) { const bool dq = __all(carry[qt] < -150.1f); live = live && !dq; }
            if (!live) continue;
            f32x4 s[2];
#pragma unroll
            for (int nt = 0; nt < 2; ++nt) { f32x4 z = (f32x4){0.f, 0.f, 0.f, 0.f}; z = MFMA16(kf[nt][0], qf[qt][0], z); s[nt] = MFMA16(kf[nt][1], qf[qt][1], z); }
            const int dbase = q0 + 16 * qt + c - k0 - 4 * g;
            if (MODE == MODE_A) {
                float mx = -1e30f;
#pragma unroll
                for (int nt = 0; nt < 2; ++nt)
#pragma unroll
                    for (int j = 0; j < 4; ++j) { const int dist = dbase - (16 * nt + j); const bool valid = (unsigned)dist < 128u;
                        const float bias2 = lutp[dist & 127];
                        const float lg = valid ? (s[nt][j] * C1 + bias2) : -1e30f; s[nt][j] = lg; mx = fmaxf(mx, lg); }
                mx = fmaxf(mx, __shfl_xor(mx, 16)); mx = fmaxf(mx, __shfl_xor(mx, 32));
                const float mnew = fmaxf(mrun[qt], mx); const float alpha = __builtin_amdgcn_exp2f(mrun[qt] - mnew); mrun[qt] = mnew;
                float ps = 0.f;
#pragma unroll
                for (int nt = 0; nt < 2; ++nt)
#pragma unroll
                    for (int j = 0; j < 4; ++j) { const float p = __builtin_amdgcn_exp2f(s[nt][j] - mnew); s[nt][j] = p; ps += p; }
                lrun[qt] = lrun[qt] * alpha + ps;
#pragma unroll
                for (int dt = 0; dt < 4; ++dt) o[qt][dt] = o[qt][dt] * alpha;
            } else {
                float lk[2][4], c4[2];
#pragma unroll
                for (int nt = 0; nt < 2; ++nt) { c4[nt] = 0.f;
#pragma unroll
                    for (int j = 0; j < 4; ++j) { const bool valid = (dbase - (16 * nt + j)) > 0; const float z = s[nt][j] * C1;
                        const float e = __builtin_amdgcn_exp2f(-fabsf(z));
                        const float sp = fmaxf(z, 0.f) + __builtin_amdgcn_logf(1.f + e);
                        lk[nt][j] = valid ? -sp : 0.f; s[nt][j] = valid ? (z - sp) : -1e30f; c4[nt] += lk[nt][j]; } }
                float after = 0.f;
#pragma unroll
                for (int nt = 1; nt >= 0; --nt) {
                    const float v1 = __shfl_xor(c4[nt], 16), v2 = __shfl_xor(c4[nt], 32), v3 = __shfl_xor(c4[nt], 48);
                    const float G = (((g ^ 1) > g) ? v1 : 0.f) + (((g ^ 2) > g) ? v2 : 0.f) + (((g ^ 3) > g) ? v3 : 0.f);
                    const float T = c4[nt] + v1 + v2 + v3;
                    float sfx = carry[qt] + after + G;
#pragma unroll
                    for (int j = 3; j >= 0; --j) { const float w = __builtin_amdgcn_exp2f(s[nt][j] + sfx); s[nt][j] = w; sfx += lk[nt][j]; }
                    after += T;
                }
                carry[qt] += after;
            }
            u32x4 w; w.x = cvtpk(s[0][0], s[0][1]); w.y = cvtpk(s[0][2], s[0][3]); w.z = cvtpk(s[1][0], s[1][1]); w.w = cvtpk(s[1][2], s[1][3]);
            const bf16x8 pb = __builtin_bit_cast(bf16x8, w);
#pragma unroll
            for (int dt = 0; dt < 4; ++dt) o[qt][dt] = MFMA16(vfr[dt], pb, o[qt][dt]);
        }
        if (MODE == MODE_C) {
            bool dn = (k0 <= q0);
#pragma unroll
            for (int qt = 0; qt < NQT; ++qt) dn = dn && (carry[qt] < -150.1f);
            if (__all(dn)) break;
        }
    }
    if (MODE == MODE_A) {
        const float sk2 = sinks[h] * LOG2E;
#pragma unroll
        for (int qt = 0; qt < NQT; ++qt) { float l = lrun[qt]; l += __shfl_xor(l, 16); l += __shfl_xor(l, 32);
            l += __builtin_amdgcn_exp2f(sk2 - mrun[qt]);
            const float inv = 1.f / l;
#pragma unroll
            for (int dt = 0; dt < 4; ++dt) o[qt][dt] = o[qt][dt] * inv; }
    }
#pragma unroll
    for (int qt = 0; qt < NQT; ++qt) { const size_t row = (size_t)b * SEQ + q0 + qt * 16 + c;
        u32x2 pk[4];
#pragma unroll
        for (int dt = 0; dt < 4; ++dt) { pk[dt].x = cvtpk(o[qt][dt][0], o[qt][dt][1]); pk[dt].y = cvtpk(o[qt][dt][2], o[qt][dt][3]); }
        store_row16(Yout + row * YP + h * 64, g, pk); }
}

__device__ __forceinline__ void item_attn_b(LAS unsigned char* lds, const bf16_t* qkv, bf16_t* Yb, const bf16_t* Ycmp, const float* relb, const unsigned* selm, int it) {
    const int t64 = 31 - (it >> 6), gk = it & 1, b = (it >> 1) & 31; const int q0 = t64 * 64; const bf16_t* base = qkv + (size_t)b * SEQ * QP;
    int tid_ = threadIdx.x; asm volatile("" : "+v"(tid_));
    const int lane = tid_ & 63, wid = tid_ >> 6, c = lane & 15, g = lane >> 4;
    const int h = gk * 4 + (wid & 3), qw0 = q0 + (wid >> 2) * 32;
    f32x4 o1[2][4], o2[2][4];
    attn_pass<MODE_BSLC>(lds, base, gk, q0, relb + 8, selm + ((size_t)b * 2 + gk) * SEQ, o1);
    attn_pass<MODE_BWIN>(lds, base, gk, q0, relb + 8, nullptr, o2);
#pragma unroll
    for (int qt = 0; qt < 2; ++qt) { const size_t row = (size_t)b * SEQ + qw0 + qt * 16 + c;
        const float g1 = sigmoidf_(bf2f(qkv[row * QP + C_BG + 8 + h])), g2 = sigmoidf_(bf2f(qkv[row * QP + C_BG + 16 + h]));
        const int par = g & 1;
#pragma unroll
        for (int pr = 0; pr < 2; ++pr) {
            const f32x4 ra = o1[qt][2 * pr] * g1 + o2[qt][2 * pr] * g2, rb = o1[qt][2 * pr + 1] * g1 + o2[qt][2 * pr + 1] * g2;
            float lo[4], hi[4];
#pragma unroll
            for (int e = 0; e < 4; ++e) { const auto sw = __builtin_amdgcn_permlane16_swap(__float_as_uint(ra[e]), __float_as_uint(rb[e]), false, false); lo[e] = __uint_as_float(sw[0]); hi[e] = __uint_as_float(sw[1]); }
            const int dofs = h * 64 + 16 * (2 * pr + par) + 4 * (g - par);
            const u32x4 old = *(const u32x4*)(Ycmp + row * 512 + dofs);
            u32x4 w; w.x = cvtpk(lo[0] + bflo(old.x), lo[1] + bfhi(old.x)); w.y = cvtpk(lo[2] + bflo(old.y), lo[3] + bfhi(old.y));
            w.z = cvtpk(hi[0] + bflo(old.z), hi[1] + bfhi(old.z)); w.w = cvtpk(hi[2] + bflo(old.w), hi[3] + bfhi(old.w));
            *(u32x4*)(Yb + row * YP + dofs) = w; } }
}

__device__ __forceinline__ void item_cmpk(const bf16_t* qkv, const bf16_t* Wb, const float* hb, bf16_t* KC, int it, int wsub) {
    int tid_ = threadIdx.x; asm volatile("" : "+v"(tid_));
    const int lane = tid_ & 63, wid = wsub, c = lane & 15, g = lane >> 4;
    const int ty = it & 1, gk = (it >> 1) & 1, b = it >> 2;
    const int n = 16 * wid + c, nn = n < 127 ? n : 126;
    const bf16_t* src = qkv + ((size_t)b * SEQ + 16 * nn) * QP + (ty ? C_BVC : C_BKC) + gk * 64 + g * 8;
    const bf16_t* w1t = Wb + W_1 + (size_t)ty * 128 * 2048 + (size_t)c * 2048 + g * 8;
    f32x4 hT[8];
#pragma unroll
    for (int ht = 0; ht < 8; ++ht) hT[ht] = (f32x4){0.f, 0.f, 0.f, 0.f};
#pragma unroll 2
    for (int ks = 0; ks < 64; ++ks) {
        const bf16x8 bfrag = *(const bf16x8*)(src + (size_t)(ks >> 1) * QP + (ks & 1) * 32);
#pragma unroll
        for (int ht = 0; ht < 8; ++ht) { const bf16x8 afrag = *(const bf16x8*)(w1t + (size_t)ht * 16 * 2048 + ks * 32); hT[ht] = MFMA16(afrag, bfrag, hT[ht]); }
    }
#pragma unroll
    for (int ht = 0; ht < 8; ++ht)
#pragma unroll
        for (int j = 0; j < 4; ++j) { const float x = hT[ht][j] + hb[ty * 128 + 16 * ht + 4 * g + j]; const float u = 0.7978845608028654f * (x + 0.044715f * x * x * x);
            const float th = 1.f - 2.f * fast_rcp(1.f + __expf(2.f * u)); hT[ht][j] = 0.5f * x * (1.f + th); }
    f32x4 oT[4];
#pragma unroll
    for (int dt = 0; dt < 4; ++dt) oT[dt] = (f32x4){0.f, 0.f, 0.f, 0.f};
    const bf16_t* w2t = Wb + W_2 + (size_t)ty * 64 * 128;
#pragma unroll
    for (int p = 0; p < 4; ++p) { u32x4 w; w.x = cvtpk(hT[2 * p][0], hT[2 * p][1]); w.y = cvtpk(hT[2 * p][2], hT[2 * p][3]); w.z = cvtpk(hT[2 * p + 1][0], hT[2 * p + 1][1]); w.w = cvtpk(hT[2 * p + 1][2], hT[2 * p + 1][3]);
        const bf16x8 bfrag = __builtin_bit_cast(bf16x8, w);
#pragma unroll
        for (int dt = 0; dt < 4; ++dt) { const bf16_t* ap = w2t + (size_t)(16 * dt + c) * 128 + 32 * p + 4 * g; const u32x2 a0 = *(const u32x2*)ap, a1 = *(const u32x2*)(ap + 16);
            u32x4 aw; aw.x = a0.x; aw.y = a0.y; aw.z = a1.x; aw.w = a1.y; oT[dt] = MFMA16(__builtin_bit_cast(bf16x8, aw), bfrag, oT[dt]); } }
    if (n < 127) { bf16_t* dst = KC + ((((size_t)ty * 32 + b) * 2 + gk) * 128 + n) * 64;
#pragma unroll
        for (int dt = 0; dt < 4; ++dt) { u32x2 w; w.x = cvtpk(oT[dt][0], oT[dt][1]); w.y = cvtpk(oT[dt][2], oT[dt][3]); *(u32x2*)(dst + 16 * dt + 4 * g) = w; } }
}

constexpr int CMP_KS = 0, CMP_KPB = 144, CMP_VT = 128 * 144, CMP_VPB = 272, CMP_IMP = 36864;
__device__ __forceinline__ void item_attn_cmp(LAS unsigned char* lds, const bf16_t* qkv, const bf16_t* KC, bf16_t* Yb, unsigned* selm, int it) {
    int tid_ = threadIdx.x; asm volatile("" : "+v"(tid_));
    const int tid = tid_, lane = tid & 63, wid = tid >> 6, c = lane & 15, g = lane >> 4;
    const int q16 = it & 15, gk = (it >> 4) & 1, b = it >> 5; const int q0 = q16 * 128;
    LAS unsigned char* Ks = lds + CMP_KS; LAS unsigned char* Vt = lds + CMP_VT;
    const bf16_t* kc = KC + (((size_t)0 * 32 + b) * 2 + gk) * 128 * 64; const bf16_t* vc = KC + (((size_t)1 * 32 + b) * 2 + gk) * 128 * 64;
    __syncthreads();
#pragma unroll
    for (int r = 0; r < 2; ++r) { const int e = tid + 512 * r; const int key = e >> 3, ch = e & 7;
        u32x4 kv = (u32x4){0u, 0u, 0u, 0u}, vv = kv;
        if (key < 127) { kv = *(const u32x4*)(kc + key * 64 + ch * 8); vv = *(const u32x4*)(vc + key * 64 + ch * 8); }
        *(LAS u32x4*)(Ks + key * CMP_KPB + ch * 16) = kv; *(LAS u32x4*)(Vt + key * CMP_KPB + ch * 16) = vv; }
    __syncthreads();
    const int t = q0 + wid * 16 + c; const size_t row = (size_t)b * SEQ + t;
    float psum[8][4];
#pragma unroll
    for (int nt = 0; nt < 8; ++nt)
#pragma unroll
        for (int j = 0; j < 4; ++j) psum[nt][j] = 0.f;
#pragma unroll 1
    for (int hh = 0; hh < 4; ++hh) {
        const int h = gk * 4 + hh;
        const bf16x8 qf0 = *(const bf16x8*)(qkv + row * QP + C_BQ + h * 64 + g * 8), qf1 = *(const bf16x8*)(qkv + row * QP + C_BQ + h * 64 + 32 + g * 8);
        f32x4 s[8]; float mx = -1e30f;
#pragma unroll
        for (int nt = 0; nt < 8; ++nt) { const bf16x8 kf0 = *(const LAS bf16x8*)(Ks + (16 * nt + c) * CMP_KPB + g * 16), kf1 = *(const LAS bf16x8*)(Ks + (16 * nt + c) * CMP_KPB + 64 + g * 16);
            f32x4 z = (f32x4){0.f, 0.f, 0.f, 0.f}; z = MFMA16(kf0, qf0, z); z = MFMA16(kf1, qf1, z);
#pragma unroll
            for (int j = 0; j < 4; ++j) { const int n = 16 * nt + 4 * g + j; const bool valid = (16 * n + 31) <= t; const float lg = valid ? z[j] * 0.125f : -1e30f; z[j] = lg; mx = fmaxf(mx, lg); }
            s[nt] = z; }
        mx = fmaxf(mx, __shfl_xor(mx, 16)); mx = fmaxf(mx, __shfl_xor(mx, 32));
        float sum = 0.f;
#pragma unroll
        for (int nt = 0; nt < 8; ++nt)
#pragma unroll
            for (int j = 0; j < 4; ++j) { const float lg = s[nt][j]; const float e = (lg > -1e29f) ? __expf(lg - mx) : 0.f; s[nt][j] = e; sum += e; }
        sum += __shfl_xor(sum, 16); sum += __shfl_xor(sum, 32);
        const float inv = sum > 0.f ? 1.f / sum : 0.f;
#pragma unroll
        for (int nt = 0; nt < 8; ++nt)
#pragma unroll
            for (int j = 0; j < 4; ++j) { const float p = s[nt][j] * inv; s[nt][j] = p; psum[nt][j] += p; }
        f32x4 o[4];
#pragma unroll
        for (int dt = 0; dt < 4; ++dt) o[dt] = (f32x4){0.f, 0.f, 0.f, 0.f};
#pragma unroll
        for (int p = 0; p < 4; ++p) { u32x4 w; w.x = cvtpk(s[2 * p][0], s[2 * p][1]); w.y = cvtpk(s[2 * p][2], s[2 * p][3]); w.z = cvtpk(s[2 * p + 1][0], s[2 * p + 1][1]); w.w = cvtpk(s[2 * p + 1][2], s[2 * p + 1][3]);
            const bf16x8 pbf = __builtin_bit_cast(bf16x8, w);
#pragma unroll
            for (int dt = 0; dt < 4; ++dt) { const bf16x8 vf = vfrag(Vt + (32 * p + 4 * g + (c >> 2)) * CMP_KPB + dt * 32 + (c & 3) * 8); o[dt] = MFMA16(vf, pbf, o[dt]); } }
        const float g0 = sigmoidf_(bf2f(qkv[row * QP + C_BG + h]));
        { u32x2 pk[4];
#pragma unroll
          for (int dt = 0; dt < 4; ++dt) { pk[dt].x = cvtpk(o[dt][0] * g0, o[dt][1] * g0); pk[dt].y = cvtpk(o[dt][2] * g0, o[dt][3] * g0); }
          store_row16(Yb + row * 512 + h * 64, g, pk); }
    }
    float imp[8], sh3[8];
#pragma unroll
    for (int nt = 0; nt < 8; ++nt) sh3[nt] = __shfl(psum[nt][3], (lane + 48) & 63);
#pragma unroll
    for (int nt = 0; nt < 8; ++nt) { const float prev = (g > 0) ? sh3[nt] : (nt > 0 ? sh3[nt > 0 ? nt - 1 : 0] : 0.f); imp[nt] = (psum[nt][0] + psum[nt][1]) + (psum[nt][2] + psum[nt][3]) + prev; }
    const int cur = t >> 6; const int nforced = cur >= 2 ? 3 : cur + 1; const int nfree = 16 - nforced;
    LAS float* impl = (LAS float*)(lds + CMP_IMP) + (wid * 16 + c) * 33;
#pragma unroll
    for (int nt = 0; nt < 8; ++nt) impl[4 * nt + g] = imp[nt];
    asm volatile("s_waitcnt lgkmcnt(0)" ::: "memory");
    int rank[8];
#pragma unroll
    for (int nt = 0; nt < 8; ++nt) rank[nt] = 0;
#pragma unroll 1
    for (int jb2 = 1; jb2 <= cur - 2; ++jb2) {
        const float v = impl[jb2];
#pragma unroll
        for (int nt = 0; nt < 8; ++nt) { const int jb = 4 * nt + g; rank[nt] += ((v > imp[nt]) || (v == imp[nt] && jb2 < jb)) ? 1 : 0; }
    }
    unsigned bits = 0u;
#pragma unroll
    for (int nt = 0; nt < 8; ++nt) { const int jb = 4 * nt + g; const bool forced = (jb == 0) || (jb == cur) || (jb == cur - 1); const bool cand = (jb >= 1) && (jb <= cur - 2);
        if (forced || (cand && rank[nt] < nfree)) bits |= (1u << jb); }
    bits |= __shfl_xor(bits, 16); bits |= __shfl_xor(bits, 32);
    if (g == 0) selm[((size_t)b * 2 + gk) * SEQ + t] = bits;
}


#define XB_TMO      128
#define XB_XCNT(j)  (256  + 64 * (j))
#define XB_XSUB(j)  (1280 + 64 * (j))
#define XB_XGEN(j)  (2304 + 64 * (j))
#define XB_TOP      3328
#define XB_TOPGEN   3392
#define XCD_BAR_WORDS 3456
#define XB_SPIN_CAP (1u << 22)
__device__ __forceinline__ unsigned xb_ld(unsigned* p)              { return __hip_atomic_load(p, __ATOMIC_RELAXED, __HIP_MEMORY_SCOPE_AGENT); }
__device__ __forceinline__ unsigned xb_add(unsigned* p, unsigned v) { return __hip_atomic_fetch_add(p, v, __ATOMIC_RELAXED, __HIP_MEMORY_SCOPE_AGENT); }
__device__ __forceinline__ unsigned xb_xcc_id() { return (unsigned)__builtin_amdgcn_s_getreg((3 << 11) | 20) & 0xFu; }
#define XB_SPIN(cond, bar) do { unsigned _sp = 0; while (cond) { __builtin_amdgcn_s_sleep(1); \
    if ((++_sp & 255u) == 0u) { if (xb_ld(&(bar)[XB_TMO])) break; if (_sp > XB_SPIN_CAP) { atomicAdd(&(bar)[XB_TMO], 1u); break; } } } } while (0)
struct XcdBarrier { unsigned* bar; unsigned x; volatile LAS unsigned* st; };
__device__ __forceinline__ XcdBarrier xcd_barrier_post(unsigned* bar, volatile LAS unsigned* st) {
    XcdBarrier b; b.bar = bar; b.x = xb_xcc_id(); b.st = st;
    if (threadIdx.x == 0) (void)xb_add(&bar[XB_XCNT(b.x)], 1u);
    return b;
}
__device__ __forceinline__ void xcd_barrier_complete(unsigned* bar, unsigned x, unsigned& nloc, unsigned& nx) {
    const unsigned G = gridDim.x * gridDim.y * gridDim.z;
    unsigned sum, cnt, mine, sp = 0u;
    for (;;) {
        sum = 0u; cnt = 0u; mine = 0u;
#pragma unroll
        for (unsigned j = 0; j < 16; ++j) { const unsigned c = xb_ld(&bar[XB_XCNT(j)]); sum += c; cnt += (c > 0u) ? 1u : 0u; mine = (j == x) ? c : mine; }
        if (sum == G) break;
        __builtin_amdgcn_s_sleep(1);
        if ((++sp & 255u) == 0u) { if (xb_ld(&bar[XB_TMO])) break; if (sp > XB_SPIN_CAP) { atomicAdd(&bar[XB_TMO], 1u); break; } }
    }
    nloc = mine > 0u ? mine : 1u; nx = cnt > 0u ? cnt : 1u;
}
__device__ __forceinline__ void xcd_barrier(const XcdBarrier& b) {
    asm volatile("s_waitcnt vmcnt(0)" ::: "memory");
    __syncthreads();
    if (threadIdx.x == 0) {
        unsigned* bar = b.bar;
        __builtin_amdgcn_s_waitcnt(0);
        unsigned nloc = b.st[0], nx = b.st[1];
        if (nloc == 0u) { xcd_barrier_complete(bar, b.x, nloc, nx); b.st[0] = nloc; b.st[1] = nx; }
        const unsigned old = xb_add(&bar[XB_XSUB(b.x)], 1u);
        const unsigned gen = old / nloc;
        if (old + 1u == (gen + 1u) * nloc) {
            __builtin_amdgcn_fence(__ATOMIC_RELEASE, "agent");
            asm volatile("s_waitcnt vmcnt(0)" ::: "memory");
            const unsigned og = xb_add(&bar[XB_TOP], 1u);
            const unsigned tg = og / nx;
            if (og + 1u == (tg + 1u) * nx) xb_add(&bar[XB_TOPGEN], 1u);
            else XB_SPIN(xb_ld(&bar[XB_TOPGEN]) == tg, bar);
            __builtin_amdgcn_fence(__ATOMIC_ACQUIRE, "agent");
            xb_add(&bar[XB_XGEN(b.x)], 1u);
            asm volatile("s_waitcnt vmcnt(0)" ::: "memory");
        } else {
            XB_SPIN(xb_ld(&bar[XB_XGEN(b.x)]) == gen, bar);
            __builtin_amdgcn_fence(__ATOMIC_ACQUIRE, "agent");
            asm volatile("s_waitcnt vmcnt(0)" ::: "memory");
        }
    }
    __syncthreads();
}

constexpr int NPHASES = 2 + DEPTH * 13;

__global__ void __launch_bounds__(512, 2) mega_fwd(Args a) {
    extern __shared__ __attribute__((aligned(16))) unsigned char lds_raw[];
    LAS unsigned char* lds = (LAS unsigned char*)lds_raw;
    cg::grid_group grid = cg::this_grid();
    volatile LAS unsigned* bst = (volatile LAS unsigned*)(lds + LDS_BYTES - 16);
    if (threadIdx.x < 4) bst[threadIdx.x] = 0u;
    __syncthreads();
    const XcdBarrier xbar = xcd_barrier_post((unsigned*)a.ws + 1024, bst);
    const int G = gridDim.x;
    const int lo = a.ph_lo, hi = a.ph_hi;
    unsigned char* ws = a.ws;
    float* mods = (float*)(ws + WS_MOD); bf16_t* KC = (bf16_t*)(ws + WS_KC); unsigned* selm = (unsigned*)(ws + WS_SEL); const float* hb = (const float*)(ws + WS_HB);
    bf16_t* Wb = (bf16_t*)(ws + WS_W); bf16_t* H = (bf16_t*)(ws + WS_H); bf16_t* BIG = (bf16_t*)(ws + WS_BIG); bf16_t* Y = (bf16_t*)(ws + WS_Y);
    bf16_t* Ya = Y; bf16_t* Yb = Y + 512; bf16_t* Yc = Y + (size_t)M * YP; bf16_t* Ycmp = (bf16_t*)(ws + WS_YCMP); bf16_t* WbT = (bf16_t*)(ws + WS_WB); bf16_t* MG = BIG + (size_t)64 * MiB / 2;
    const float* x_in = a.in[0]; const float* relb = a.in[2]; const float* ln_pre = a.in[5]; const float* ln_post = a.in[6];
    enum { K_MODS, K_INIT, K_G1, K_G2, K_ROW, K_GIN, K_ATT1, K_CMP, K_ATTB, K_FUSED, K_OUT };
    for (int ph = lo; ph < hi; ++ph) {
        int kind, l = 0, i = 0;
        if (ph == 0) kind = K_MODS; else if (ph == 1) kind = K_INIT;
        else { const int r = ph - 2; l = r / 13; const int q = r - 13 * l;
            if (q < 3) { i = 0; kind = q == 0 ? K_G1 : q == 1 ? K_G2 : K_ROW; }
            else if (q < 10) { i = 1; kind = q == 3 ? K_GIN : q == 4 ? K_ATT1 : q == 5 ? K_CMP : q == 6 ? K_ATTB : q == 7 ? K_FUSED : q == 8 ? K_OUT : K_ROW; }
            else { i = 2; kind = q == 10 ? K_G1 : q == 11 ? K_G2 : K_ROW; } }
        const int nrep = NREP(kind);
        for (int rep = 0; rep < nrep; ++rep) {
        if (rep) xcd_barrier(xbar);
        if (kind == K_G1 || kind == K_G2 || kind == K_GIN || kind == K_FUSED || kind == K_OUT) {
            const int j = i >> 1;
            pg8::Gemm g; pg8::EpiGen E; pg8::StaticOrder S_;
            E.sG = BIG + (size_t)blockIdx.x * 131072; E.sM = E.sG + 65536;
            const bf16_t* Ag; const bf16_t* Bg; int Nn, Kk;
            if (kind == K_G1) { Ag = H; Bg = Wb + W_GU + (size_t)j * 5632 * DM; Nn = 5632; Kk = DM; S_.em = 2; E.O = BIG; E.ldc = FF; E.ncols = 5632; }
            else if (kind == K_G2) { Ag = BIG; Bg = Wb + W_D + (size_t)j * DM * FF; Nn = DM; Kk = FF; S_.em = 0; E.O = Y; E.ldc = DM; E.ncols = DM; }
            else if (kind == K_GIN) { Ag = H; Bg = Wb + W_IN; Nn = NIN; Kk = DM; S_.em = 0; E.O = BIG; E.ldc = QP; E.ncols = QP; }
            else if (kind == K_FUSED) { Ag = H; Bg = Wb + W_IN + (size_t)NIN * DM; Nn = DM; Kk = DM; S_.em = 5; E.O = MG; E.ldc = DM; E.ncols = DM; }
            else { Ag = MG; Bg = Wb + W_O; Nn = DM; Kk = DM; S_.em = 0; E.O = Y; E.ldc = DM; E.ncols = DM; }
            g.ld = Kk;
            S_.init(M, Nn, G, (int)blockIdx.x);
            S_.A = (const char*)Ag; S_.B = (const char*)Bg; S_.tstep = (size_t)256 * Kk * 2; S_.nt = Kk / 64;
            S_.fused = (kind == K_FUSED) ? 1 : 0;
            S_.Hh = (const char*)H; S_.Wmg = (const char*)(Wb + W_IN + (size_t)NIN * DM); S_.Yab = (const char*)Y; S_.Yc = (const char*)Yc; S_.WbT = (const char*)WbT;
            { int tq_ = threadIdx.x; asm volatile("" : "+v"(tq_)); pg8::utab_build(lds, S_, tq_); }
            pg8::TabSched T_{lds};
            pg8::gemm_phase<pg8::EpiGen>(lds, g, T_, E);
        } else if (kind == K_MODS) {
            if (G > 200) { if ((int)blockIdx.x < 144) phase_mods(lds, a.in[1], a.in[3], a.in[4], mods, 144); else phase_conv(lds, a, 0, 144, G - 144); }
            else { phase_mods(lds, a.in[1], a.in[3], a.in[4], mods, G); phase_conv(lds, a, 0, 0, G); }
        } else if (kind == K_INIT || kind == K_ROW) {
            const bool init = (kind == K_INIT);
            const bool last = (!init && l == DEPTH - 1 && i == 2);
            const int ln_ = init ? 0 : (i == 2 ? l + 1 : l), in_ = init ? 0 : (i == 2 ? 0 : i + 1);
            if (!init && i == 2 && !last) phase_conv(lds, a, l + 1, 0, G);
            const bool first = init || (l == 0 && i == 0), l3i1 = (!init && l == DEPTH - 1 && i == 1);
            const void* xs_ = first ? (const void*)x_in : last ? (const void*)Yc : (const void*)a.out;
            void* xd_ = l3i1 ? (void*)Yc : (void*)a.out;
            phase_rowwise(xs_, !first, xd_, !last, Y, H, mods, l, i, ln_post + ((size_t)l * 3 + i) * DM, i == 1 ? 1.0f : 0.5f, last ? 0 : ln_, in_, ln_pre + ((size_t)(last ? 0 : ln_) * 3 + in_) * DM, !init, !last);
        } else if (kind == K_ATT1) {
            {
                LAS float* lt = (LAS float*)(lds + AW_LUT);
                int t0_ = threadIdx.x; asm volatile("" : "+v"(t0_));
                for (int e = t0_; e < 8 * 128; e += 512) lt[e] = relb[(int)T5B[e & 127] * 16 + (e >> 7)] * 1.4426950408889634f;
                __syncthreads();
            }
            int t1_ = threadIdx.x; asm volatile("" : "+v"(t1_));
            const int wv = blockIdx.x * 8 + __builtin_amdgcn_readfirstlane(t1_ >> 6), NWV = G * 8;
            (void)wv; (void)NWV;
            unsigned* qctr = (unsigned*)a.ws + 8192 + ph;
            for (;;) {
                unsigned v_ = 0u; if ((t1_ & 63) == 0) v_ = atomicAdd(qctr, 1u);
                const int it = (int)__builtin_amdgcn_readfirstlane(v_);
                if (it >= 1024 + 8192 + 8192) break;
                if (it < 1024) item_cmpk(BIG, Wb, hb, KC, it >> 3, it & 7);
                else if (it < 1024 + 8192) attn_wave<MODE_C>(lds, BIG, Yc, nullptr, it - 1024);
                else attn_wave<MODE_A>(lds, BIG, Ya, a.in[11] + l * 8, it - 1024 - 8192);
            }
        } else if (kind == K_CMP) {
            for (int it = blockIdx.x; it < 1024; it += G) item_attn_cmp(lds, BIG, KC, Ycmp, selm, it);
        } else {
            unsigned* qctr = (unsigned*)a.ws + 8192 + ph;
            volatile LAS unsigned* qslot = (volatile LAS unsigned*)(lds + LDS_BYTES - 32);
            for (;;) {
                __syncthreads();
                if (threadIdx.x == 0) qslot[0] = atomicAdd(qctr, 1u);
                __syncthreads();
                const int it = (int)qslot[0];
                if (it >= 2048) break;
                item_attn_b(lds, BIG, Yb, Ycmp, relb, selm, it);
            }
        }
        __syncthreads();
        }
        if (ph + 1 < hi) { if (ph == 0) grid.sync(); else xcd_barrier(xbar); }
    }
}

extern "C" void kernel_launch(void* const* d_in, const int* in_sizes, int n_in, void* d_out, int out_size, void* d_ws, size_t ws_size, hipStream_t stream) {
    static int grid = 0;
    if (grid == 0) {
        if (n_in != 17 || in_sizes[0] != M * DM || out_size != M * DM || ws_size < WS_END) { fprintf(stderr, "kernel_launch: unexpected shapes / workspace (n_in %d ws %zu)\n", n_in, ws_size); grid = -1; return; }
        int dev = 0, cus = 0, per_cu = 0;
        (void)hipGetDevice(&dev); (void)hipDeviceGetAttribute(&cus, hipDeviceAttributeMultiprocessorCount, dev);
        (void)hipFuncSetAttribute((const void*)mega_fwd, hipFuncAttributeMaxDynamicSharedMemorySize, LDS_BYTES);
        (void)hipOccupancyMaxActiveBlocksPerMultiprocessor(&per_cu, (const void*)mega_fwd, 512, LDS_BYTES);
        if (per_cu < 1) per_cu = 1;
        grid = cus * per_cu;
        (void)hipGetLastError();
    }
    if (grid < 0) return;
    if (hipMemsetAsync(d_ws, 0, 65536, stream) != hipSuccess) { fprintf(stderr, "kernel_launch: memset of barrier words failed\n"); return; }
    Args a{};
    for (int i = 0; i < 17; ++i) a.in[i] = (const float*)d_in[i];
    a.out = (float*)d_out; a.ws = (unsigned char*)d_ws;
#if MK_PER_PHASE_LAUNCH
    for (int p = 0; p < NPHASES; ++p) { a.ph_lo = p; a.ph_hi = p + 1; hipLaunchKernelGGL(mega_fwd, dim3(grid), dim3(512), LDS_BYTES, stream, a); }
#else
    a.ph_lo = 0; a.ph_hi = NPHASES;
    void* args[] = {&a};
    hipError_t e = hipLaunchCooperativeKernel((const void*)mega_fwd, dim3(grid), dim3(512), args, LDS_BYTES, stream);
    if (e != hipSuccess) fprintf(stderr, "cooperative launch failed: %s (grid %d)\n", hipGetErrorString(e), grid);
#endif
}
```
